# Optimizing an MI355X kernel written in HIP

```python
import math
import jax, jax.numpy as jnp
from jax import lax
import numpy as np

D_MODEL = 1024
BATCH = 4
SEQ = 4096
DEPTH = 2

D_FF = 2816
NORM_EPS = 1e-6
Q_BLOCK = 128
ROPE_THETA = 500000.0
MIX_WIDTH = D_MODEL

DIFF_HEADS = 4
DIFF_HEAD_DIM = 64
DIFF_V_DIM = 2 * DIFF_HEAD_DIM
DIFF_WIDTH = DIFF_HEADS * DIFF_V_DIM
DIFF_QK_COLS = DIFF_HEADS * 2 * DIFF_HEAD_DIM
ROT_DIM = DIFF_HEAD_DIM // 4
DIFF_LAMBDA_INIT = 0.8 - 0.6 * math.exp(-0.3 * 0)

S5_WIDTH = MIX_WIDTH - DIFF_WIDTH
S5_GROUP = 16
S5_GROUPS = S5_WIDTH // S5_GROUP
S5_STATE = 64
L0_IN = 2 * DIFF_QK_COLS + DIFF_WIDTH + S5_WIDTH

MLSTM_HEADS = 4
MLSTM_QK_DIM = 64
MLSTM_V_DIM = 128
MLSTM_WIDTH = MLSTM_HEADS * MLSTM_V_DIM
MLSTM_QK_COLS = 2 * MLSTM_HEADS * MLSTM_QK_DIM
MLSTM_CHUNK = 64
MLSTM_CONV = 4

FOX_HEADS = 8
FOX_HEAD_DIM = 64
FOX_WIDTH = FOX_HEADS * FOX_HEAD_DIM
L1_IN = MLSTM_QK_COLS + MLSTM_WIDTH + 2 * MLSTM_HEADS + MLSTM_WIDTH + 3 * FOX_WIDTH + FOX_HEADS

kernel_name = "hybrid_diffattn_s5_mlstm_fox_macaron"


def _rmsnorm(x, g):
    x32 = x.astype(jnp.float32)
    y = x32 * lax.rsqrt(jnp.mean(x32 * x32, axis=-1, keepdims=True) + NORM_EPS)
    return (y * g.astype(jnp.float32)).astype(x.dtype)


def _swiglu(h, w_gate, w_up, w_down):
    return (jax.nn.silu(h @ w_gate) * (h @ w_up)) @ w_down


def _rope_tables(S):
    pos = jnp.arange(S, dtype=jnp.float32)
    inv = ROPE_THETA ** (-jnp.arange(0, ROT_DIM, 2, dtype=jnp.float32) / ROT_DIM)
    ang = pos[:, None] * inv[None, :]
    return jnp.cos(ang), jnp.sin(ang)


def _partial_rope(x, cos, sin):
    half = ROT_DIM // 2
    x1 = x[..., :half]
    x2 = x[..., half:ROT_DIM]
    c = cos.astype(x.dtype)
    s = sin.astype(x.dtype)
    return jnp.concatenate([x1 * c - x2 * s, x2 * c + x1 * s, x[..., ROT_DIM:]], axis=-1)


def _causal_conv(x, w, b):
    K, C = w.shape
    y = lax.conv_general_dilated(x, w[:, None, :].astype(x.dtype), window_strides=(1,),
                                 padding=[(K - 1, 0)], dimension_numbers=('NWC', 'WIO', 'NWC'),
                                 feature_group_count=C)
    return y + b.astype(x.dtype)


def _diff_attention(q, k, v, lam, subln):
    B, H, _, S, d = q.shape
    scale = d ** -0.5
    kpos = jnp.arange(S)

    def block(i):
        qb = lax.dynamic_slice_in_dim(q, i * Q_BLOCK, Q_BLOCK, axis=3)
        s = jnp.einsum('bhcqd,bhckd->bhcqk', qb, k).astype(jnp.float32) * scale
        qpos = i * Q_BLOCK + jnp.arange(Q_BLOCK)
        s = jnp.where(kpos[None, :] <= qpos[:, None], s, -jnp.inf)
        p = jax.nn.softmax(s, axis=-1)
        p = p[:, :, 0] - lam * p[:, :, 1]
        return jnp.einsum('bhqk,bhkd->bhqd', p.astype(v.dtype), v)

    o = lax.map(block, jnp.arange(S // Q_BLOCK))
    o = jnp.moveaxis(o, 0, 2).reshape(B, H, S, v.shape[-1])
    o = _rmsnorm(o, subln) * (1.0 - DIFF_LAMBDA_INIT)
    return o.transpose(0, 2, 1, 3).reshape(B, S, H * v.shape[-1])


def _s5(u, a_re, a_im, log_dt, b_re, b_im, c_re, c_im, d_skip, w_glu, b_glu):
    B, S, W = u.shape
    f32 = jnp.float32
    u32 = u.astype(f32).reshape(B, S, S5_GROUPS, S5_GROUP)
    lr, li = a_re.astype(f32), a_im.astype(f32)
    dt = jnp.exp(log_dt.astype(f32))[:, None]
    mag = jnp.exp(lr * dt)
    ar, ai = mag * jnp.cos(li * dt), mag * jnp.sin(li * dt)
    den = lr * lr + li * li
    gr = ((ar - 1.0) * lr + ai * li) / den
    gi = (ai * lr - (ar - 1.0) * li) / den
    br, bi = b_re.astype(f32), b_im.astype(f32)
    bbr = gr[..., None] * br - gi[..., None] * bi
    bbi = gr[..., None] * bi + gi[..., None] * br
    xr = jnp.einsum('bsgh,gph->sbgp', u32, bbr)
    xi = jnp.einsum('bsgh,gph->sbgp', u32, bbi)
    are = jnp.broadcast_to(ar[None, None], (S, 1, S5_GROUPS, S5_STATE))
    aim = jnp.broadcast_to(ai[None, None], (S, 1, S5_GROUPS, S5_STATE))

    def combine(e1, e2):
        a1r, a1i, b1r, b1i = e1
        a2r, a2i, b2r, b2i = e2
        return (a2r * a1r - a2i * a1i, a2r * a1i + a2i * a1r,
                a2r * b1r - a2i * b1i + b2r, a2r * b1i + a2i * b1r + b2i)

    _, _, hr, hi = lax.associative_scan(combine, (are, aim, xr, xi), axis=0)
    y = (jnp.einsum('ghp,sbgp->bsgh', c_re.astype(f32), hr)
         - jnp.einsum('ghp,sbgp->bsgh', c_im.astype(f32), hi)).reshape(B, S, W)
    y = y + d_skip.astype(f32) * u32.reshape(B, S, W)
    z = jax.nn.gelu(y)
    out = z * jax.nn.sigmoid(z @ w_glu.astype(f32) + b_glu.astype(f32))
    return out.astype(u.dtype)


def _mlstm_chunkwise(q, k, v, ig, lf):
    B, H, S, dk = q.shape
    dv = v.shape[-1]
    T = MLSTM_CHUNK
    NC = S // T
    f32 = jnp.float32

    def chunks(a):
        return jnp.moveaxis(a.astype(f32).reshape(a.shape[:2] + (NC, T) + a.shape[3:]), 2, 0)

    xs = (chunks(q), chunks(k), chunks(v), chunks(ig), chunks(lf))
    tri = jnp.tril(jnp.ones((T, T), dtype=bool))

    def step(carry, inp):
        C, n, m = carry
        qc, kc, vc, ic, fc = inp
        bcum = jnp.cumsum(fc, axis=-1)
        Dm = bcum[..., :, None] - bcum[..., None, :] + ic[..., None, :]
        Dm = jnp.where(tri, Dm, -jnp.inf)
        g = bcum + m[..., None]
        mt = jnp.maximum(g, jnp.max(Dm, axis=-1))
        w_intra = jnp.exp(Dm - mt[..., None])
        w_inter = jnp.exp(g - mt)
        s = jnp.einsum('bhtd,bhsd->bhts', qc, kc) * w_intra
        num = w_inter[..., None] * jnp.einsum('bhtd,bhde->bhte', qc, C) + jnp.einsum('bhts,bhse->bhte', s, vc)
        den = w_inter * jnp.einsum('bhtd,bhd->bht', qc, n) + jnp.sum(s, axis=-1)
        h = num / jnp.maximum(jnp.abs(den), jnp.exp(-mt))[..., None]
        bT = bcum[..., -1]
        dec = bT[..., None] - bcum + ic
        m_new = jnp.maximum(bT + m, jnp.max(dec, axis=-1))
        w_s = jnp.exp(dec - m_new[..., None])
        carry_w = jnp.exp(bT + m - m_new)
        C_new = carry_w[..., None, None] * C + jnp.einsum('bhs,bhsd,bhse->bhde', w_s, kc, vc)
        n_new = carry_w[..., None] * n + jnp.einsum('bhs,bhsd->bhd', w_s, kc)
        return (C_new, n_new, m_new), h

    init = (jnp.zeros((B, H, dk, dv), f32), jnp.zeros((B, H, dk), f32), jnp.zeros((B, H), f32))
    _, hs = lax.scan(step, init, xs)
    return jnp.moveaxis(hs, 0, 2).reshape(B, H, S, dv)


def _forgetting_attention(q, k, v, logf):
    B, H, S, d = q.shape
    scale = d ** -0.5
    F = jnp.cumsum(logf, axis=-1)
    kpos = jnp.arange(S)

    def block(i):
        qb = lax.dynamic_slice_in_dim(q, i * Q_BLOCK, Q_BLOCK, axis=2)
        Fq = lax.dynamic_slice_in_dim(F, i * Q_BLOCK, Q_BLOCK, axis=2)
        s = jnp.einsum('bhqd,bhkd->bhqk', qb, k).astype(jnp.float32) * scale
        s = s + Fq[..., :, None] - F[..., None, :]
        qpos = i * Q_BLOCK + jnp.arange(Q_BLOCK)
        s = jnp.where(kpos[None, :] <= qpos[:, None], s, -jnp.inf)
        p = jax.nn.softmax(s, axis=-1)
        return jnp.einsum('bhqk,bhkd->bhqd', p.astype(v.dtype), v)

    o = lax.map(block, jnp.arange(S // Q_BLOCK))
    o = jnp.moveaxis(o, 0, 2).reshape(B, H, S, d)
    return o.transpose(0, 2, 1, 3).reshape(B, S, H * d)


def _mixer_diff_s5(h, w_in, lq1, lk1, lq2, lk2, subln, a_re, a_im, log_dt, b_re, b_im,
                   c_re, c_im, d_skip, w_glu, b_glu, w_out):
    B, S, _ = h.shape
    proj = h @ w_in
    q, k, v, u = jnp.split(proj, [DIFF_QK_COLS, 2 * DIFF_QK_COLS, 2 * DIFF_QK_COLS + DIFF_WIDTH], axis=-1)
    q = q.reshape(B, S, DIFF_HEADS, 2, DIFF_HEAD_DIM).transpose(0, 2, 3, 1, 4)
    k = k.reshape(B, S, DIFF_HEADS, 2, DIFF_HEAD_DIM).transpose(0, 2, 3, 1, 4)
    v = v.reshape(B, S, DIFF_HEADS, DIFF_V_DIM).transpose(0, 2, 1, 3)
    cos, sin = _rope_tables(S)
    q = _partial_rope(q, cos, sin)
    k = _partial_rope(k, cos, sin)
    f32 = jnp.float32
    lam = (jnp.exp(jnp.sum(lq1.astype(f32) * lk1.astype(f32)))
           - jnp.exp(jnp.sum(lq2.astype(f32) * lk2.astype(f32))) + DIFF_LAMBDA_INIT)
    ya = _diff_attention(q, k, v, lam, subln)
    yb = _s5(u, a_re, a_im, log_dt, b_re, b_im, c_re, c_im, d_skip, w_glu, b_glu)
    return jnp.concatenate([ya, yb], axis=-1) @ w_out


def _mixer_mlstm_fox(h, w_in, conv_w, conv_b, b_i, b_f, out_norm, fox_b_f, w_out):
    B, S, _ = h.shape
    proj = h @ w_in
    sizes = [MLSTM_QK_COLS, MLSTM_WIDTH, MLSTM_HEADS, MLSTM_HEADS, MLSTM_WIDTH,
             FOX_WIDTH, FOX_WIDTH, FOX_WIDTH]
    idx, acc = [], 0
    for sz in sizes:
        acc += sz
        idx.append(acc)
    qk_m, v_m, i_m, f_m, o_m, q_f, k_f, v_f, f_f = jnp.split(proj, idx, axis=-1)
    f32 = jnp.float32
    qk_m = jax.nn.silu(_causal_conv(qk_m, conv_w, conv_b))
    q_m, k_m = jnp.split(qk_m, 2, axis=-1)
    q_m = q_m.reshape(B, S, MLSTM_HEADS, MLSTM_QK_DIM).transpose(0, 2, 1, 3) * (MLSTM_QK_DIM ** -0.5)
    k_m = k_m.reshape(B, S, MLSTM_HEADS, MLSTM_QK_DIM).transpose(0, 2, 1, 3)
    v_m = v_m.reshape(B, S, MLSTM_HEADS, MLSTM_V_DIM).transpose(0, 2, 1, 3)
    ig = (i_m.astype(f32) + b_i.astype(f32)).transpose(0, 2, 1)
    lf = jax.nn.log_sigmoid(f_m.astype(f32) + b_f.astype(f32)).transpose(0, 2, 1)
    hm = _mlstm_chunkwise(q_m, k_m, v_m, ig, lf).astype(h.dtype)
    hm = _rmsnorm(hm.transpose(0, 2, 1, 3), out_norm).reshape(B, S, MLSTM_WIDTH)
    hm = jax.nn.sigmoid(o_m) * hm
    q_f = q_f.reshape(B, S, FOX_HEADS, FOX_HEAD_DIM).transpose(0, 2, 1, 3)
    k_f = k_f.reshape(B, S, FOX_HEADS, FOX_HEAD_DIM).transpose(0, 2, 1, 3)
    v_f = v_f.reshape(B, S, FOX_HEADS, FOX_HEAD_DIM).transpose(0, 2, 1, 3)
    logf = jax.nn.log_sigmoid(f_f.astype(f32) + fox_b_f.astype(f32)).transpose(0, 2, 1)
    hf = _forgetting_attention(q_f, k_f, v_f, logf)
    return jnp.concatenate([hm, hf], axis=-1) @ w_out


def setup_inputs(seed: int = 0) -> dict:
    key = jax.random.key(seed)
    keys = iter(jax.random.split(key, 64))
    f32 = jnp.float32

    def nrm(shape, scale):
        return jax.random.normal(next(keys), shape, f32) * scale

    def gain(shape):
        return 1.0 + nrm(shape, 0.02)

    def ffn():
        return (gain((D_MODEL,)), nrm((D_MODEL, D_FF), D_MODEL ** -0.5),
                nrm((D_MODEL, D_FF), D_MODEL ** -0.5), nrm((D_FF, D_MODEL), D_FF ** -0.5))

    inp = {}
    inp['x'] = nrm((BATCH, SEQ, D_MODEL), 1.0)
    g, wg, wu, wd = ffn()
    inp['l0_ffn1_norm'], inp['l0_ffn1_w_gate'], inp['l0_ffn1_w_up'], inp['l0_ffn1_w_down'] = g, wg, wu, wd
    inp['l0_mix_norm'] = gain((D_MODEL,))
    inp['l0_w_in'] = nrm((D_MODEL, L0_IN), D_MODEL ** -0.5)
    inp['l0_diff_lambda_q1'] = nrm((DIFF_HEAD_DIM,), 0.1)
    inp['l0_diff_lambda_k1'] = nrm((DIFF_HEAD_DIM,), 0.1)
    inp['l0_diff_lambda_q2'] = nrm((DIFF_HEAD_DIM,), 0.1)
    inp['l0_diff_lambda_k2'] = nrm((DIFF_HEAD_DIM,), 0.1)
    inp['l0_diff_subln'] = gain((DIFF_V_DIM,))
    inp['l0_s5_a_re'] = -0.5 + nrm((S5_GROUPS, S5_STATE), 0.01)
    inp['l0_s5_a_im'] = math.pi * jnp.arange(S5_STATE, dtype=f32)[None, :] + nrm((S5_GROUPS, S5_STATE), 0.01)
    inp['l0_s5_log_dt'] = jax.random.uniform(next(keys), (S5_GROUPS,), f32, math.log(1e-3), math.log(1e-1))
    inp['l0_s5_b_re'] = nrm((S5_GROUPS, S5_STATE, S5_GROUP), (2 * S5_GROUP) ** -0.5)
    inp['l0_s5_b_im'] = nrm((S5_GROUPS, S5_STATE, S5_GROUP), (2 * S5_GROUP) ** -0.5)
    inp['l0_s5_c_re'] = nrm((S5_GROUPS, S5_GROUP, S5_STATE), (2 * S5_STATE) ** -0.5)
    inp['l0_s5_c_im'] = nrm((S5_GROUPS, S5_GROUP, S5_STATE), (2 * S5_STATE) ** -0.5)
    inp['l0_s5_d'] = nrm((S5_WIDTH,), 1.0)
    inp['l0_s5_w_glu'] = nrm((S5_WIDTH, S5_WIDTH), S5_WIDTH ** -0.5)
    inp['l0_s5_b_glu'] = nrm((S5_WIDTH,), 0.01)
    inp['l0_w_out'] = nrm((MIX_WIDTH, D_MODEL), MIX_WIDTH ** -0.5)
    g, wg, wu, wd = ffn()
    inp['l0_ffn2_norm'], inp['l0_ffn2_w_gate'], inp['l0_ffn2_w_up'], inp['l0_ffn2_w_down'] = g, wg, wu, wd
    g, wg, wu, wd = ffn()
    inp['l1_ffn1_norm'], inp['l1_ffn1_w_gate'], inp['l1_ffn1_w_up'], inp['l1_ffn1_w_down'] = g, wg, wu, wd
    inp['l1_mix_norm'] = gain((D_MODEL,))
    inp['l1_w_in'] = nrm((D_MODEL, L1_IN), D_MODEL ** -0.5)
    inp['l1_mlstm_conv_w'] = nrm((MLSTM_CONV, MLSTM_QK_COLS), MLSTM_CONV ** -0.5)
    inp['l1_mlstm_conv_b'] = nrm((MLSTM_QK_COLS,), 0.01)
    inp['l1_mlstm_b_i'] = nrm((MLSTM_HEADS,), 0.1)
    inp['l1_mlstm_b_f'] = jnp.linspace(3.0, 6.0, MLSTM_HEADS, dtype=f32) + nrm((MLSTM_HEADS,), 0.1)
    inp['l1_mlstm_out_norm'] = gain((MLSTM_HEADS, MLSTM_V_DIM))
    inp['l1_fox_b_f'] = jnp.linspace(1.0, 4.0, FOX_HEADS, dtype=f32) + nrm((FOX_HEADS,), 0.1)
    inp['l1_w_out'] = nrm((MIX_WIDTH, D_MODEL), MIX_WIDTH ** -0.5)
    g, wg, wu, wd = ffn()
    inp['l1_ffn2_norm'], inp['l1_ffn2_w_gate'], inp['l1_ffn2_w_up'], inp['l1_ffn2_w_down'] = g, wg, wu, wd
    inp['final_norm'] = gain((D_MODEL,))
    return inp


def reference(x,
              l0_ffn1_norm, l0_ffn1_w_gate, l0_ffn1_w_up, l0_ffn1_w_down,
              l0_mix_norm, l0_w_in,
              l0_diff_lambda_q1, l0_diff_lambda_k1, l0_diff_lambda_q2, l0_diff_lambda_k2, l0_diff_subln,
              l0_s5_a_re, l0_s5_a_im, l0_s5_log_dt, l0_s5_b_re, l0_s5_b_im, l0_s5_c_re, l0_s5_c_im,
              l0_s5_d, l0_s5_w_glu, l0_s5_b_glu,
              l0_w_out,
              l0_ffn2_norm, l0_ffn2_w_gate, l0_ffn2_w_up, l0_ffn2_w_down,
              l1_ffn1_norm, l1_ffn1_w_gate, l1_ffn1_w_up, l1_ffn1_w_down,
              l1_mix_norm, l1_w_in,
              l1_mlstm_conv_w, l1_mlstm_conv_b, l1_mlstm_b_i, l1_mlstm_b_f, l1_mlstm_out_norm,
              l1_fox_b_f,
              l1_w_out,
              l1_ffn2_norm, l1_ffn2_w_gate, l1_ffn2_w_up, l1_ffn2_w_down,
              final_norm):
    ffn1 = [(l0_ffn1_norm, l0_ffn1_w_gate, l0_ffn1_w_up, l0_ffn1_w_down),
            (l1_ffn1_norm, l1_ffn1_w_gate, l1_ffn1_w_up, l1_ffn1_w_down)]
    ffn2 = [(l0_ffn2_norm, l0_ffn2_w_gate, l0_ffn2_w_up, l0_ffn2_w_down),
            (l1_ffn2_norm, l1_ffn2_w_gate, l1_ffn2_w_up, l1_ffn2_w_down)]
    mix_norms = [l0_mix_norm, l1_mix_norm]

    def mixer_even(h):
        return _mixer_diff_s5(h, l0_w_in, l0_diff_lambda_q1, l0_diff_lambda_k1, l0_diff_lambda_q2,
                              l0_diff_lambda_k2, l0_diff_subln, l0_s5_a_re, l0_s5_a_im, l0_s5_log_dt,
                              l0_s5_b_re, l0_s5_b_im, l0_s5_c_re, l0_s5_c_im, l0_s5_d, l0_s5_w_glu,
                              l0_s5_b_glu, l0_w_out)

    def mixer_odd(h):
        return _mixer_mlstm_fox(h, l1_w_in, l1_mlstm_conv_w, l1_mlstm_conv_b, l1_mlstm_b_i,
                                l1_mlstm_b_f, l1_mlstm_out_norm, l1_fox_b_f, l1_w_out)

    mixers = [mixer_even, mixer_odd]
    for layer in range(DEPTH):
        g1, wg1, wu1, wd1 = ffn1[layer]
        x = x + 0.5 * _swiglu(_rmsnorm(x, g1), wg1, wu1, wd1)
        x = x + mixers[layer](_rmsnorm(x, mix_norms[layer]))
        g2, wg2, wu2, wd2 = ffn2[layer]
        x = x + 0.5 * _swiglu(_rmsnorm(x, g2), wg2, wu2, wd2)
    return _rmsnorm(x, final_norm)
```

```cpp
#include <hip/hip_runtime.h>
#include <hip/hip_cooperative_groups.h>
#include <cstdio>
#include <cmath>
namespace cg = cooperative_groups;

#define PG8_LAS __attribute__((address_space(3)))
#define DI __device__ __forceinline__
typedef unsigned short bf16_t;
typedef short bf16x8 __attribute__((ext_vector_type(8)));
typedef float f32x4 __attribute__((ext_vector_type(4)));
typedef float f32x2 __attribute__((ext_vector_type(2)));
typedef float f32x16 __attribute__((ext_vector_type(16)));
typedef unsigned u32x4 __attribute__((ext_vector_type(4)));
typedef unsigned u32x2 __attribute__((ext_vector_type(2)));
typedef __bf16 bf16x2n __attribute__((ext_vector_type(2)));

constexpr int MT = 16384, DM = 1024, SEQ = 4096, FFH = 2816;
constexpr float LOG2E = 1.4426950408889634f;
constexpr float NEPS = 1e-6f;

constexpr size_t SZ_WGU = (size_t)5632 * 1024 * 2, SZ_WD = (size_t)1024 * 2816 * 2, SZ_FFN = SZ_WGU + SZ_WD;
constexpr size_t OFF_WIN0 = 4 * SZ_FFN;
constexpr size_t OFF_WGLU = OFF_WIN0 + (size_t)2048 * 1024 * 2;
constexpr size_t OFF_WOUT0 = OFF_WGLU + (size_t)512 * 512 * 2;
constexpr size_t OFF_WIN1 = OFF_WOUT0 + (size_t)1024 * 1024 * 2;
constexpr size_t OFF_WOUT1 = OFF_WIN1 + (size_t)3328 * 1024 * 2;
constexpr size_t OFF_XB = OFF_WOUT1 + (size_t)1024 * 1024 * 2;
constexpr size_t OFF_SSQ = OFF_XB + (size_t)MT * 1024 * 2;
constexpr size_t OFF_ROPE = OFF_SSQ + (size_t)16 * MT * 4;
constexpr size_t OFF_GATES = OFF_ROPE + (size_t)4096 * 8 * 8;
constexpr size_t OFF_MA = OFF_GATES + (size_t)MT * 16 * 4;
constexpr size_t OFF_MM = OFF_MA + (size_t)16 * 4096 * 4;
constexpr size_t OFF_MTT = OFF_MM + (size_t)16 * 4096 * 4;
constexpr size_t OFF_FF = OFF_MTT + (size_t)16 * 4096 * 4;
constexpr size_t OFF_S5E = OFF_FF + (size_t)32 * 4096 * 4;
constexpr size_t OFF_SCAL = OFF_S5E + (size_t)128 * 32 * 64 * 8;
constexpr size_t OFF_U = OFF_SCAL + 256;
constexpr size_t OFF_HID = OFF_U;
constexpr size_t OFF_P0 = OFF_U, OFF_VT0 = OFF_P0 + (size_t)MT * 1536 * 2, OFF_YC0 = OFF_VT0 + (size_t)512 * MT * 2, OFF_Z = OFF_YC0 + (size_t)MT * 1024 * 2;
constexpr size_t OFF_P1 = OFF_U, OFF_VT1 = OFF_P1 + (size_t)MT * 2048 * 2, OFF_YC1 = OFF_VT1 + (size_t)1024 * MT * 2;
constexpr size_t WS_END = OFF_YC1 + (size_t)MT * 1024 * 2;
constexpr size_t OFF_QKC = OFF_XB;
static_assert(WS_END <= (size_t)256 * 1024 * 1024, "workspace");
static_assert(OFF_Z + (size_t)MT * 512 * 2 <= WS_END, "workspace L0");

constexpr int LDS_BYTES = 131072 + 1024;
constexpr int LDS_MISC = 131072;

struct Params { const float* in[45]; float* out; unsigned char* ws; float inv_freq[8]; };
typedef const __attribute__((address_space(4))) Params* KPtr;
DI int otid() { int t = threadIdx.x; asm volatile("" : "+v"(t)); return t; }
DI int osgpr(int v) { asm volatile("" : "+s"(v)); return v; }
DI KPtr launder_kp() { KPtr q = (KPtr)__builtin_amdgcn_kernarg_segment_ptr(); asm volatile("" : "+s"(q)); return q; }

DI bf16_t f2bf(float f) { unsigned u = __float_as_uint(f); u += 0x7fffu + ((u >> 16) & 1u); return (bf16_t)(u >> 16); }
DI float bf2f(bf16_t b) { return __uint_as_float(((unsigned)b) << 16); }
DI unsigned pack2(float a, float b) { f32x2 v = {a, b}; bf16x2n r = __builtin_convertvector(v, bf16x2n); return __builtin_bit_cast(unsigned, r); }
DI float bflo(unsigned w) { return __uint_as_float(w << 16); }
DI float bfhi(unsigned w) { return __uint_as_float(w & 0xffff0000u); }
DI float fast_rcp(float x) { return __builtin_amdgcn_rcpf(x); }
DI float fast_exp2(float x) { return __builtin_amdgcn_exp2f(x); }
DI float sigmoidf_(float x) { return fast_rcp(1.0f + __expf(-x)); }

namespace pg8 {
constexpr int BM = 256, BK = 64, HALF = 128, HTB = HALF * BK * 2, STAGE_BYTES = 8 * HTB, NXCD = 8, WGM = 8;
__host__ __device__ __forceinline__ int lds_byte(int r, int c) { const int st = (r >> 4) * 2 + (c >> 5), rr = r & 15, cc = c & 31, ob = rr * 64 + cc * 2; return st * 1024 + (ob ^ (((ob >> 9) & 1) << 5)); }
__host__ __device__ __forceinline__ void stage_rc(int b, int& R, int& C) { const int st = b / 1024, sb = b % 1024, swz = sb ^ (((sb >> 9) & 1) << 5); R = (st >> 1) * 16 + swz / 64; C = (st & 1) * 32 + (swz % 64) / 2; }
__host__ __device__ __forceinline__ int perm32(int rho) { const int n = rho >> 4, i = rho & 15; return 8 * (i >> 2) + 4 * n + (i & 3); }
struct Unit { int pm, pn, kind; };
DI void decode_unit(int L, int nM, int nN, int& pm, int& pn) {
    const int nwg = nM * nN; int wgid = L; { const int q = nwg / NXCD, r = nwg % NXCD, xcd = wgid % NXCD, off = wgid / NXCD; wgid = (xcd < r ? xcd * (q + 1) : r * (q + 1) + (xcd - r) * q) + off; }
    const int nig = WGM * nN, gid = wgid / nig, fm = gid * WGM, gsz = (nM - fm) < WGM ? (nM - fm) : WGM;
    pm = fm + ((wgid % nig) % gsz); pn = (wgid % nig) / gsz;
}
struct Sched2 {
    int n1M, n1N, n1, n2M, n2N, n2, G, c; const char *A1, *B1, *A2, *B2;
    DI bool next(int i, Unit& u) const {
        long L = (long)i * G + c;
        if (L < n1) { decode_unit((int)L, n1M, n1N, u.pm, u.pn); u.kind = 0; return true; }
        L -= n1;
        if (L < n2) { decode_unit((int)L, n2M, n2N, u.pm, u.pn); u.kind = 1; return true; }
        return false;
    }
    DI const char* aptr(const Unit& u, size_t tstep) const { return (u.kind ? A2 : A1) + (size_t)u.pm * tstep; }
    DI const char* bptr(const Unit& u, size_t tstep) const { return (u.kind ? B2 : B1) + (size_t)u.pn * tstep; }
    DI void a_ready(const Unit&) const {}
    DI void done(const Unit&) const {}
};
DI long long wall_clock64_() { return 0; }
#define wall_clock64 wall_clock64_
template <class Epi, class Sched, bool STAMP = false>
__device__ __forceinline__ void gemm_phase(PG8_LAS unsigned char* lds, const int Kdim, const Sched& S, const Epi& E, unsigned long long* stamps) {
    const int tid = otid(), wid = __builtin_amdgcn_readfirstlane(tid >> 6), lane = tid & 63, wr = wid >> 2, wc = wid & 3, fr = lane & 15, fq = lane >> 4;
    const int K = Kdim, nt = K / BK;
    int ts_lo = 0, ts_hi = 0, nts = 0; const unsigned long long rt_entry = STAMP ? (unsigned long long)wall_clock64() : 0ull;
#define PG8_STAMP() do { if (STAMP && wid == 0 && nts < 64) { const unsigned long long _c = (unsigned long long)clock64(); \
        ts_lo = (lane == nts) ? (int)(unsigned)_c : ts_lo; ts_hi = (lane == nts) ? (int)(unsigned)(_c >> 32) : ts_hi; ++nts; } } while (0)
    PG8_STAMP();
    unsigned voffA[2], voffB[2];
#pragma unroll
    for (int i = 0; i < 2; ++i) { int R, C; stage_rc(tid * 16 + i * 8192, R, C); const int Rb = Epi::PERM ? ((R & ~31) + perm32(R & 31)) : R;
        voffA[i] = (unsigned)(R * K + C) * 2u; voffB[i] = (unsigned)(Rb * K + C) * 2u; }
    const size_t kstep = (size_t)(BK * 2);
    const size_t hstep = (size_t)HALF * K * 2;
    const size_t tstep = 2 * hstep;
    const unsigned ldsw = (unsigned)wid * 1024u;
    const int aoff = lds_byte(wr * 64 + fr, fq * 8), boff = lds_byte(wc * 32 + fr, fq * 8);
#define PG8_SA(b, h) (((b) * 2 + (h)) * HTB)
#define PG8_SB(b, h) ((4 + (b) * 2 + (h)) * HTB)
#define PG8_STAGE(bufoff, gbase, voff) do { _Pragma("unroll") for (int _i = 0; _i < 2; ++_i) \
        __builtin_amdgcn_global_load_lds((const unsigned*)((const char*)(gbase) + (voff)[_i]), (PG8_LAS unsigned*)(lds + (bufoff) + ldsw + _i * 8192), 16, 0, 0); } while (0)
#define PG8_LDA(dst, b, h) do { _Pragma("unroll") for (int m = 0; m < 4; ++m) _Pragma("unroll") for (int k = 0; k < 2; ++k) dst[m][k] = *(const PG8_LAS bf16x8*)(lds + PG8_SA(b, h) + aoff + m * 2048 + k * 1024); } while (0)
#define PG8_LDB(dst, b, h) do { _Pragma("unroll") for (int n = 0; n < 2; ++n) _Pragma("unroll") for (int k = 0; k < 2; ++k) dst[n][k] = *(const PG8_LAS bf16x8*)(lds + PG8_SB(b, h) + boff + n * 2048 + k * 1024); } while (0)
#define PG8_MMA(ai, bj, At, Bt) do { __builtin_amdgcn_s_setprio(1); _Pragma("unroll") for (int m = 0; m < 4; ++m) _Pragma("unroll") for (int n = 0; n < 2; ++n) _Pragma("unroll") for (int k = 0; k < 2; ++k) \
        acc[ai][bj][m][n] = __builtin_amdgcn_mfma_f32_16x16x32_bf16(Bt[n][k], At[m][k], acc[ai][bj][m][n], 0, 0, 0); __builtin_amdgcn_s_setprio(0); } while (0)
#define PG8_WAIT_V(n) asm volatile("s_waitcnt vmcnt(" #n ")" ::: "memory")
#define PG8_WAIT_L(n) asm volatile("s_waitcnt lgkmcnt(" #n ")" ::: "memory")
#define PG8_BAR __builtin_amdgcn_s_barrier()
#define PG8_SCHED __builtin_amdgcn_sched_barrier(0)
    Unit cur, nxt; int ui = 0;
    if (!S.next(0, cur)) return;
    f32x4 acc[2][2][4][2];
#pragma unroll
    for (int a = 0; a < 2; ++a)
#pragma unroll
        for (int b = 0; b < 2; ++b)
#pragma unroll
            for (int m = 0; m < 4; ++m)
#pragma unroll
                for (int n = 0; n < 2; ++n) acc[a][b][m][n] = (f32x4){0.f, 0.f, 0.f, 0.f};
    bf16x8 At[4][2], B0[2][2], B1[2][2];
    const char* cA = S.aptr(cur, tstep); const char* cB = S.bptr(cur, tstep);
    S.a_ready(cur);
    PG8_STAGE(PG8_SB(0, 0), cB, voffB); PG8_STAGE(PG8_SA(0, 0), cA, voffA); PG8_STAGE(PG8_SB(0, 1), cB + hstep, voffB); PG8_STAGE(PG8_SA(0, 1), cA + hstep, voffA);
    if (wr == 1) PG8_BAR;
    PG8_WAIT_V(4); PG8_BAR;
    PG8_STAGE(PG8_SB(1, 0), cB + kstep, voffB); PG8_STAGE(PG8_SA(1, 0), cA + kstep, voffA); PG8_STAGE(PG8_SB(1, 1), cB + hstep + kstep, voffB);
    PG8_WAIT_V(6); PG8_BAR;
    PG8_STAMP();
    for (;;) {
        const bool has_next = S.next(ui + 1, nxt);
        const char* nA = has_next ? S.aptr(nxt, tstep) : cA; const char* nB = has_next ? S.bptr(nxt, tstep) : cB;
        for (int t = 0; t < nt; t += 2) {
            const bool last = (t == nt - 2);
            const char* a1 = cA + (size_t)(t + 1) * kstep;
            const char* a2 = last ? nA : cA + (size_t)(t + 2) * kstep; const char* b2 = last ? nB : cB + (size_t)(t + 2) * kstep;
            const char* a3 = a2 + kstep; const char* b3 = b2 + kstep;
            if (last && has_next) S.a_ready(nxt);
            PG8_LDB(B0, 0, 0); PG8_SCHED; PG8_LDA(At, 0, 0); PG8_STAGE(PG8_SA(1, 1), a1 + hstep, voffA);
            PG8_WAIT_L(8); PG8_BAR; PG8_WAIT_L(0); PG8_MMA(0, 0, At, B0); PG8_BAR; PG8_SCHED;
            PG8_LDB(B1, 0, 1); PG8_STAGE(PG8_SB(0, 0), b2, voffB);
            PG8_BAR; PG8_WAIT_L(0); PG8_MMA(0, 1, At, B1); PG8_BAR;
            PG8_LDA(At, 0, 1); PG8_STAGE(PG8_SA(0, 0), a2, voffA);
            PG8_BAR; PG8_WAIT_L(0); PG8_MMA(1, 0, At, B0); PG8_BAR; PG8_SCHED;
            PG8_STAGE(PG8_SB(0, 1), b2 + hstep, voffB);
            PG8_WAIT_V(6); PG8_BAR; PG8_MMA(1, 1, At, B1); PG8_BAR;
            PG8_LDB(B0, 1, 0); PG8_SCHED; PG8_LDA(At, 1, 0); PG8_STAGE(PG8_SA(0, 1), a2 + hstep, voffA);
            PG8_WAIT_L(8); PG8_BAR; PG8_WAIT_L(0); PG8_MMA(0, 0, At, B0); PG8_BAR; PG8_SCHED;
            PG8_LDB(B1, 1, 1); PG8_STAGE(PG8_SB(1, 0), b3, voffB);
            PG8_BAR; PG8_WAIT_L(0); PG8_MMA(0, 1, At, B1); PG8_BAR;
            PG8_LDA(At, 1, 1); PG8_STAGE(PG8_SA(1, 0), a3, voffA);
            PG8_BAR; PG8_WAIT_L(0); PG8_MMA(1, 0, At, B0); PG8_BAR; PG8_SCHED;
            PG8_STAGE(PG8_SB(1, 1), b3 + hstep, voffB);
            PG8_WAIT_V(6); PG8_BAR; PG8_MMA(1, 1, At, B1); PG8_BAR;
        }
        PG8_STAMP();
        if constexpr (!Epi::AFTER_DRAIN) { E(acc, cur, wr, wc, fr, fq); S.done(cur); }
        PG8_STAMP();
        if (!has_next) break;
#pragma unroll
        for (int a = 0; a < 2; ++a)
#pragma unroll
            for (int b = 0; b < 2; ++b)
#pragma unroll
                for (int m = 0; m < 4; ++m)
#pragma unroll
                    for (int n = 0; n < 2; ++n) acc[a][b][m][n] = (f32x4){0.f, 0.f, 0.f, 0.f};
        cur = nxt; cA = nA; cB = nB; ++ui;
    }
    PG8_WAIT_V(0);
    if (wr == 0) PG8_BAR;
    PG8_BAR;
    if constexpr (Epi::AFTER_DRAIN) { E.fused(acc, cur, wr, wc, fr, fq, lds, wid, lane); S.done(cur); }
    PG8_STAMP();
    if (STAMP && wid == 0) { stamps[lane] = lane < nts ? (((unsigned long long)(unsigned)ts_hi << 32) | (unsigned)ts_lo) : 0ull;
        if (lane == 62) stamps[62] = rt_entry; if (lane == 63) stamps[63] = (unsigned long long)wall_clock64(); }
#undef PG8_STAMP
#undef PG8_SA
#undef PG8_SB
#undef PG8_STAGE
#undef PG8_LDA
#undef PG8_LDB
#undef PG8_MMA
#undef PG8_WAIT_V
#undef PG8_WAIT_L
#undef PG8_BAR
#undef PG8_SCHED
}
#undef wall_clock64
}
using pg8::Unit;
typedef f32x4 AccT[2][2][4][2];

DI void row_rstd(const float* ssq, int row0, int fq, float (&rs)[2][4]) {
#pragma unroll
    for (int ai = 0; ai < 2; ++ai)
#pragma unroll
        for (int m = 0; m < 4; ++m) {
            const int row = row0 + ai * 128 + m * 16; float s = 0.f;
#pragma unroll
            for (int q = 0; q < 4; ++q) s += ssq[(size_t)(4 * fq + q) * MT + row];
            s += __shfl_xor(s, 16); s += __shfl_xor(s, 32);
            rs[ai][m] = rsqrtf(s * (1.0f / 1024.0f) + NEPS);
        }
}
DI u32x4 pack8(const f32x4& a, const f32x4& b) { u32x4 w; w.x = pack2(a[0], a[1]); w.y = pack2(a[2], a[3]); w.z = pack2(b[0], b[1]); w.w = pack2(b[2], b[3]); return w; }
DI void epi_vt(const AccT& acc, const Unit& u, int wr, int wc, int fr, int fq, const float* ssq, bf16_t* vt) {
    const int tokb = u.pn * 256 + wc * 32 + 8 * fq;
    f32x4 rt[2][2];
#pragma unroll
    for (int bj = 0; bj < 2; ++bj)
#pragma unroll
        for (int n = 0; n < 2; ++n) {
            f32x4 s = *(const f32x4*)(ssq + (size_t)fr * MT + tokb + bj * 128 + n * 4);
#pragma unroll
            for (int off = 1; off < 16; off <<= 1) { s[0] += __shfl_xor(s[0], off); s[1] += __shfl_xor(s[1], off); s[2] += __shfl_xor(s[2], off); s[3] += __shfl_xor(s[3], off); }
#pragma unroll
            for (int j = 0; j < 4; ++j) s[j] = rsqrtf(s[j] * (1.0f / 1024.0f) + NEPS);
            rt[bj][n] = s;
        }
#pragma unroll
    for (int ai = 0; ai < 2; ++ai)
#pragma unroll
        for (int m = 0; m < 4; ++m) {
            const int row = u.pm * 256 + ai * 128 + wr * 64 + m * 16 + fr;
#pragma unroll
            for (int bj = 0; bj < 2; ++bj) {
                const f32x4 v0 = acc[ai][bj][m][0] * rt[bj][0], v1 = acc[ai][bj][m][1] * rt[bj][1];
                *(u32x4*)(vt + (size_t)row * MT + tokb + bj * 128) = pack8(v0, v1);
            }
        }
}

struct EpiGateUp {
    static constexpr bool PERM = true, AFTER_DRAIN = false;
    const float* ssq; bf16_t* hid;
    DI void operator()(const AccT& acc, const Unit& u, int wr, int wc, int fr, int fq) const {
        const int row0 = u.pm * 256 + wr * 64 + fr; float rs[2][4]; row_rstd(ssq, row0, fq, rs);
        const int colh = u.pn * 128 + wc * 32 + 8 * fq;
#pragma unroll
        for (int ai = 0; ai < 2; ++ai)
#pragma unroll
            for (int m = 0; m < 4; ++m) {
                const float r = rs[ai][m]; f32x4 h0, h1;
#pragma unroll
                for (int j = 0; j < 4; ++j) {
                    const float g0 = acc[ai][0][m][0][j] * r, g1 = acc[ai][0][m][1][j] * r, u0 = acc[ai][1][m][0][j] * r, u1 = acc[ai][1][m][1][j] * r;
                    h0[j] = g0 * sigmoidf_(g0) * u0; h1[j] = g1 * sigmoidf_(g1) * u1;
                }
                *(u32x4*)(hid + (size_t)(row0 + ai * 128 + m * 16) * FFH + colh) = pack8(h0, h1);
            }
    }
};
struct EpiResid {
    static constexpr bool PERM = false, AFTER_DRAIN = false;
    const float* xin; float* xout; bf16_t* xb; float* ssq; float scale;
    DI void operator()(const AccT& acc, const Unit& u, int wr, int wc, int fr, int fq) const {
        const int row0 = u.pm * 256 + wr * 64 + fr, col0 = u.pn * 256 + wc * 32 + 4 * fq;
#pragma unroll
        for (int ai = 0; ai < 2; ++ai)
#pragma unroll
            for (int m = 0; m < 4; ++m) {
                const int row = row0 + ai * 128 + m * 16; float ss = 0.f;
#pragma unroll
                for (int bj = 0; bj < 2; ++bj)
#pragma unroll
                    for (int n = 0; n < 2; ++n) {
                        const size_t o = (size_t)row * DM + col0 + bj * 128 + n * 16;
                        const f32x4 xr = *(const f32x4*)(xin + o); const f32x4 xn = xr + acc[ai][bj][m][n] * scale;
                        *(f32x4*)(xout + o) = xn;
                        u32x2 w; w.x = pack2(xn[0], xn[1]); w.y = pack2(xn[2], xn[3]); *(u32x2*)(xb + o) = w;
                        ss += (xn[0] * xn[0] + xn[1] * xn[1]) + (xn[2] * xn[2] + xn[3] * xn[3]);
                    }
                ss += __shfl_xor(ss, 16); ss += __shfl_xor(ss, 32);
                if (fq == 0) ssq[(size_t)(4 * u.pn + wc) * MT + row] = ss;
            }
    }
};
struct EpiWin0 {
    static constexpr bool PERM = true, AFTER_DRAIN = false;
    const float* ssq; bf16_t* p0; bf16_t* vt; const f32x2* rope;
    DI void operator()(const AccT& acc, const Unit& u, int wr, int wc, int fr, int fq) const {
        if (u.kind) { epi_vt(acc, u, wr, wc, fr, fq, ssq, vt); return; }
        const int row0 = u.pm * 256 + wr * 64 + fr; float rs[2][4]; row_rstd(ssq, row0, fq, rs);
        const bool rot = (u.pn < 4) && !(wc & 1) && (fq < 2);
#pragma unroll
        for (int ai = 0; ai < 2; ++ai)
#pragma unroll
            for (int m = 0; m < 4; ++m) {
                const int row = row0 + ai * 128 + m * 16; const float r = rs[ai][m]; const int pos = row & (SEQ - 1);
#pragma unroll
                for (int bj = 0; bj < 2; ++bj) {
                    f32x4 v0 = acc[ai][bj][m][0] * r, v1 = acc[ai][bj][m][1] * r;
                    if (rot) {
                        const f32x2* tb = rope + pos * 8 + 4 * fq;
#pragma unroll
                        for (int j = 0; j < 4; ++j) { const f32x2 cs = tb[j]; const float x1 = v0[j], x2 = v1[j]; v0[j] = x1 * cs.x - x2 * cs.y; v1[j] = x2 * cs.x + x1 * cs.y; }
                    }
                    *(u32x4*)(p0 + (size_t)row * 1536 + u.pn * 256 + bj * 128 + wc * 32 + 8 * fq) = pack8(v0, v1);
                }
            }
    }
};
struct EpiWin1 {
    static constexpr bool PERM = true, AFTER_DRAIN = false;
    const float* ssq; bf16_t* p1; bf16_t* vt; float* gates;
    DI void operator()(const AccT& acc, const Unit& u, int wr, int wc, int fr, int fq) const {
        if (u.kind) { epi_vt(acc, u, wr, wc, fr, fq, ssq, vt); return; }
        const int row0 = u.pm * 256 + wr * 64 + fr; float rs[2][4]; row_rstd(ssq, row0, fq, rs);
#pragma unroll
        for (int ai = 0; ai < 2; ++ai)
#pragma unroll
            for (int m = 0; m < 4; ++m) {
                const int row = row0 + ai * 128 + m * 16; const float r = rs[ai][m];
                if (u.pn < 8) {
#pragma unroll
                    for (int bj = 0; bj < 2; ++bj) {
                        const f32x4 v0 = acc[ai][bj][m][0] * r, v1 = acc[ai][bj][m][1] * r;
                        *(u32x4*)(p1 + (size_t)row * 2048 + u.pn * 256 + bj * 128 + wc * 32 + 8 * fq) = pack8(v0, v1);
                    }
                } else if (wc == 0 && fq < 2) {
                    *(f32x4*)(gates + (size_t)row * 16 + 8 * fq) = acc[ai][0][m][0] * r;
                    *(f32x4*)(gates + (size_t)row * 16 + 8 * fq + 4) = acc[ai][0][m][1] * r;
                }
            }
    }
};
struct EpiGLU {
    static constexpr bool PERM = true, AFTER_DRAIN = false;
    const bf16_t* z; const float* bias; bf16_t* ycat;
    DI void operator()(const AccT& acc, const Unit& u, int wr, int wc, int fr, int fq) const {
        const int row0 = u.pm * 256 + wr * 64 + fr, colb = u.pn * 256 + wc * 32 + 8 * fq;
#pragma unroll
        for (int bj = 0; bj < 2; ++bj) {
            const int col = colb + bj * 128;
            const f32x4 b0 = *(const f32x4*)(bias + col), b1 = *(const f32x4*)(bias + col + 4);
#pragma unroll
            for (int ai = 0; ai < 2; ++ai)
#pragma unroll
                for (int m = 0; m < 4; ++m) {
                    const int row = row0 + ai * 128 + m * 16;
                    const u32x4 zz = *(const u32x4*)(z + (size_t)row * 512 + col);
                    const f32x4 g0 = acc[ai][bj][m][0] + b0, g1 = acc[ai][bj][m][1] + b1; f32x4 o0, o1;
                    o0[0] = bflo(zz.x) * sigmoidf_(g0[0]); o0[1] = bfhi(zz.x) * sigmoidf_(g0[1]); o0[2] = bflo(zz.y) * sigmoidf_(g0[2]); o0[3] = bfhi(zz.y) * sigmoidf_(g0[3]);
                    o1[0] = bflo(zz.z) * sigmoidf_(g1[0]); o1[1] = bfhi(zz.z) * sigmoidf_(g1[1]); o1[2] = bflo(zz.w) * sigmoidf_(g1[2]); o1[3] = bfhi(zz.w) * sigmoidf_(g1[3]);
                    *(u32x4*)(ycat + (size_t)row * 1024 + 512 + col) = pack8(o0, o1);
                }
        }
    }
};

struct Job { const float* W; const float* W2; const float* gain; bf16_t* dst; int K, ldw, nrows, kind; };
DI int ffn_base(int f) { return f == 0 ? 1 : (f == 1 ? 23 : (f == 2 ? 27 : 40)); }
DI Job get_job(KPtr p, int j) {
    Job J; J.W2 = nullptr; J.gain = nullptr; J.kind = 0;
    if (j < 4) { const int nb = ffn_base(j); J.W = p->in[nb + 1]; J.W2 = p->in[nb + 2]; J.gain = p->in[nb]; J.dst = (bf16_t*)(p->ws + (size_t)j * SZ_FFN); J.K = 1024; J.ldw = FFH; J.nrows = 5632; J.kind = 1; }
    else if (j < 8) { const int nb = ffn_base(j - 4); J.W = p->in[nb + 3]; J.dst = (bf16_t*)(p->ws + (size_t)(j - 4) * SZ_FFN + SZ_WGU); J.K = FFH; J.ldw = 1024; J.nrows = 1024; }
    else if (j == 8) { J.W = p->in[6]; J.gain = p->in[5]; J.dst = (bf16_t*)(p->ws + OFF_WIN0); J.K = 1024; J.ldw = 2048; J.nrows = 2048; J.kind = 2; }
    else if (j == 9) { J.W = p->in[20]; J.dst = (bf16_t*)(p->ws + OFF_WGLU); J.K = 512; J.ldw = 512; J.nrows = 512; }
    else if (j == 10) { J.W = p->in[22]; J.dst = (bf16_t*)(p->ws + OFF_WOUT0); J.K = 1024; J.ldw = 1024; J.nrows = 1024; }
    else if (j == 11) { J.W = p->in[32]; J.gain = p->in[31]; J.dst = (bf16_t*)(p->ws + OFF_WIN1); J.K = 1024; J.ldw = 3088; J.nrows = 3328; J.kind = 3; }
    else { J.W = p->in[39]; J.dst = (bf16_t*)(p->ws + OFF_WOUT1); J.K = 1024; J.ldw = 1024; J.nrows = 1024; }
    return J;
}
DI int job_tiles(int j) { return j < 4 ? 352 : (j < 8 ? 176 : (j == 8 ? 128 : (j == 9 ? 16 : (j == 11 ? 208 : 64)))); }
DI int map_col(int kind, int n, bool& w2) {
    w2 = false;
    if (kind == 0) return n;
    if (kind == 1) { w2 = (n >> 7) & 1; return (n >> 8) * 128 + (n & 127); }
    if (kind == 2) {
        if (n < 1024) { const int pos = n & 63, base = n - pos; int lg = pos; if (pos < 16) lg = pos < 8 ? (pos < 4 ? pos : pos + 4) : (pos < 12 ? pos - 4 : pos); return base + lg; }
        if (n < 1536) return 1536 + (n - 1024);
        return 1024 + (n - 1536);
    }
    if (n < 512) return n;
    if (n < 1024) return 1032 + (n - 512);
    if (n < 1536) return 1544 + (n - 1024);
    if (n < 2048) return 2056 + (n - 1536);
    if (n < 2304) { const int j = n - 2048; return j < 4 ? 1024 : (j < 8 ? 1028 : (j < 16 ? 3080 + (j - 8) : -1)); }
    if (n < 2816) return 512 + (n - 2304);
    return 2568 + (n - 2816);
}
DI void phase_prep(KPtr p, unsigned char* lds) {
    const int tid = otid(), lane = tid & 63, wid = tid >> 6;
    if (blockIdx.x == 0 && tid == 0) {
        float s1 = 0.f, s2 = 0.f;
        for (int i = 0; i < 64; ++i) { s1 += p->in[7][i] * p->in[8][i]; s2 += p->in[9][i] * p->in[10][i]; }
        float* sc = (float*)(p->ws + OFF_SCAL); sc[0] = expf(s1) - expf(s2) + 0.2f;
        unsigned* ctr = (unsigned*)(p->ws + OFF_SCAL) + 8; for (int i = 0; i < 8; ++i) ctr[i] = 0u;
    }
    for (int idx = blockIdx.x * 512 + tid; idx < 4096 * 8; idx += gridDim.x * 512) {
        const int pos = idx >> 3, i = idx & 7; float fi = p->inv_freq[0];
        fi = i == 1 ? p->inv_freq[1] : fi; fi = i == 2 ? p->inv_freq[2] : fi; fi = i == 3 ? p->inv_freq[3] : fi; fi = i == 4 ? p->inv_freq[4] : fi; fi = i == 5 ? p->inv_freq[5] : fi; fi = i == 6 ? p->inv_freq[6] : fi; fi = i == 7 ? p->inv_freq[7] : fi;
        const float angf = (float)pos * fi; const double a = (double)angf; const double kk = rint(a * 0.15915494309189535); const double r = a - kk * 6.283185307179586;
        const float fr = (float)(r * 0.15915494309189535);
        f32x2 cs; cs.x = __builtin_amdgcn_cosf(fr); cs.y = __builtin_amdgcn_sinf(fr);
        ((f32x2*)(p->ws + OFF_ROPE))[idx] = cs;
    }
    {
        const float* x = p->in[0]; bf16_t* xb = (bf16_t*)(p->ws + OFF_XB); float* ssq = (float*)(p->ws + OFF_SSQ);
        for (int row = blockIdx.x * 8 + wid; row < MT; row += gridDim.x * 8) {
            float ss = 0.f;
#pragma unroll
            for (int i = 0; i < 4; ++i) {
                const size_t o = (size_t)row * DM + i * 256 + lane * 4; const f32x4 v = *(const f32x4*)(x + o);
                u32x2 w; w.x = pack2(v[0], v[1]); w.y = pack2(v[2], v[3]); *(u32x2*)(xb + o) = w;
                ss += (v[0] * v[0] + v[1] * v[1]) + (v[2] * v[2] + v[3] * v[3]);
            }
#pragma unroll
            for (int off = 1; off < 64; off <<= 1) ss += __shfl_xor(ss, off);
            if (lane < 16) ssq[(size_t)lane * MT + row] = lane == 0 ? ss : 0.f;
        }
    }
    bf16_t* T = (bf16_t*)lds;
    for (int t = blockIdx.x; t < 2592; t += gridDim.x) {
        int j = 0, tt = t; while (tt >= job_tiles(j)) { tt -= job_tiles(j); ++j; }
        const Job J = get_job(p, j); const int nkt = J.K >> 7; const int n0 = (tt / nkt) * 128, k0 = (tt % nkt) * 128;
        const int nq = tid & 31, kr = tid >> 5; bool w2; const int sc = map_col(J.kind, n0 + 4 * nq, w2); const float* Ws = w2 ? J.W2 : J.W;
        f32x4 v[8];
#pragma unroll
        for (int i = 0; i < 8; ++i) { const int k = k0 + kr + 16 * i; v[i] = sc >= 0 ? *(const f32x4*)(Ws + (size_t)k * J.ldw + sc) : (f32x4){0.f, 0.f, 0.f, 0.f}; }
#pragma unroll
        for (int i = 0; i < 8; ++i) { const int kl = kr + 16 * i; const float g = J.gain ? J.gain[k0 + kl] : 1.0f;
#pragma unroll
            for (int e = 0; e < 4; ++e) T[(4 * nq + e) * 130 + kl] = f2bf(v[i][e] * g); }
        __syncthreads();
        { const int n = tid >> 2, ks = tid & 3; const unsigned* src = (const unsigned*)(T + n * 130 + 32 * ks); bf16_t* d = J.dst + (size_t)(n0 + n) * J.K + k0 + 32 * ks;
#pragma unroll
          for (int q = 0; q < 4; ++q) { u32x4 w; w.x = src[4 * q]; w.y = src[4 * q + 1]; w.z = src[4 * q + 2]; w.w = src[4 * q + 3]; *(u32x4*)(d + 8 * q) = w; } }
        __syncthreads();
    }
}
#define MFMA32(a, b, c) __builtin_amdgcn_mfma_f32_32x32x16_bf16((a), (b), (c), 0, 0, 0)
#define MFMA16(a, b, c) __builtin_amdgcn_mfma_f32_16x16x32_bf16((a), (b), (c), 0, 0, 0)
constexpr int AT_GRP = 26880, AT_V = 9216, AT_S = 26624;
template <int MODE, int DV>
DI void attn_item(KPtr p, unsigned char* ldsb, int b, int hp, int qblk) {
    constexpr int NDB = DV / 32;
    const int tid = otid(), lane = tid & 63, wid = tid >> 6, g = wid >> 2, w = wid & 3, r = lane & 31, h = lane >> 5, tg = tid & 255;
    const int tok0 = b * SEQ, head = 2 * hp + g;
    const bf16_t *Qb, *Kb, *Vt; int ld; const float* ksc = nullptr;
    if (MODE == 0) { const bf16_t* P0 = (const bf16_t*)(p->ws + OFF_P0); Qb = P0 + hp * 128 + g * 64; Kb = P0 + 512 + hp * 128 + g * 64; ld = 1536; Vt = (const bf16_t*)(p->ws + OFF_VT0) + (size_t)(hp * 128) * MT; }
    else if (MODE == 1) { const bf16_t* P1 = (const bf16_t*)(p->ws + OFF_P1); Qb = P1 + 1024 + head * 64; Kb = P1 + 1536 + head * 64; ld = 2048; Vt = (const bf16_t*)(p->ws + OFF_VT1) + (size_t)(512 + head * 64) * MT; ksc = (const float*)(p->ws + OFF_FF) + (size_t)(b * 8 + head) * SEQ; }
    else { const bf16_t* QK = (const bf16_t*)(p->ws + OFF_QKC); Qb = QK + head * 64; Kb = QK + 256 + head * 64; ld = 512; Vt = (const bf16_t*)(p->ws + OFF_VT1) + (size_t)(head * 128) * MT; ksc = (const float*)(p->ws + OFF_MA) + (size_t)(b * 4 + head) * SEQ; }
    unsigned char* Kl = ldsb + g * AT_GRP; unsigned char* Vl = Kl + AT_V; float* Sl = (float*)(Kl + AT_S);
    const int qpos = 128 * qblk + 32 * w + r; const size_t tq = (size_t)tok0 + qpos;
    bf16x8 qf[4];
#pragma unroll
    for (int ks = 0; ks < 4; ++ks) qf[ks] = *(const bf16x8*)(Qb + tq * ld + 16 * ks + 8 * h);
    float Fref = 0.f, Mlq = 0.f, mtq = 0.f;
    if (MODE == 1) Fref = ksc[128 * qblk];
    if (MODE == 2) { Mlq = ((const float*)(p->ws + OFF_MM))[(size_t)(b * 4 + head) * SEQ + qpos]; mtq = ((const float*)(p->ws + OFF_MTT))[(size_t)(b * 4 + head) * SEQ + qpos]; }
    f32x16 O[NDB];
#pragma unroll
    for (int d = 0; d < NDB; ++d)
#pragma unroll
        for (int i = 0; i < 16; ++i) O[d][i] = 0.f;
    float m_run = -1e30f, lsum = 0.f;
    const int nkt = 2 * (qblk + 1), ktmax = 2 * qblk + (w >> 1);
    u32x4 kreg[2], vreg[DV / 32]; float sreg = 0.f;
#define AT_LOAD(kt_) do { const size_t key0 = (size_t)tok0 + 64 * (kt_); \
        _Pragma("unroll") for (int i_ = 0; i_ < 2; ++i_) { const int c_ = tg + 256 * i_; kreg[i_] = *(const u32x4*)(Kb + (key0 + (c_ >> 3)) * ld + (c_ & 7) * 8); } \
        _Pragma("unroll") for (int i_ = 0; i_ < DV / 32; ++i_) { const int c_ = tg + 256 * i_; vreg[i_] = *(const u32x4*)(Vt + (size_t)(c_ >> 3) * MT + key0 + (c_ & 7) * 8); } \
        if (MODE != 0 && tg < 64) sreg = ksc[64 * (kt_) + tg]; } while (0)
    AT_LOAD(0);
    for (int kt = 0; kt < nkt; ++kt) {
        __syncthreads();
#pragma unroll
        for (int i = 0; i < 2; ++i) { const int c = tg + 256 * i; *(u32x4*)(Kl + (c >> 3) * 144 + (c & 7) * 16) = kreg[i]; }
#pragma unroll
        for (int i = 0; i < DV / 32; ++i) { const int c = tg + 256 * i; unsigned char* d = Vl + (c >> 3) * 136 + (c & 7) * 16; u32x2 lo, hi; lo.x = vreg[i].x; lo.y = vreg[i].y; hi.x = vreg[i].z; hi.y = vreg[i].w; *(u32x2*)d = lo; *(u32x2*)(d + 8) = hi; }
        if (MODE != 0 && tg < 64) Sl[tg] = (MODE == 1) ? (Fref - sreg) * 8.0f : sreg;
        __syncthreads();
        if (kt + 1 < nkt) AT_LOAD(kt + 1);
        if (kt <= ktmax) {
            const bool diag = kt >= 2 * qblk;
            f32x16 sacc[2];
#pragma unroll
            for (int kb = 0; kb < 2; ++kb) {
                if (MODE == 1) {
#pragma unroll
                    for (int gq = 0; gq < 4; ++gq) { const f32x4 bv = *(const f32x4*)(Sl + 32 * kb + 8 * gq + 4 * h); sacc[kb][4 * gq] = bv[0]; sacc[kb][4 * gq + 1] = bv[1]; sacc[kb][4 * gq + 2] = bv[2]; sacc[kb][4 * gq + 3] = bv[3]; }
                } else {
#pragma unroll
                    for (int i = 0; i < 16; ++i) sacc[kb][i] = 0.f;
                }
#pragma unroll
                for (int ks = 0; ks < 4; ++ks) { const bf16x8 a = *(const bf16x8*)(Kl + (32 * kb + r) * 144 + 32 * ks + 16 * h); sacc[kb] = MFMA32(a, qf[ks], sacc[kb]); }
            }
            if (MODE != 2) {
                const float c = 0.125f * LOG2E;
                if (diag) {
#pragma unroll
                    for (int kb = 0; kb < 2; ++kb)
#pragma unroll
                        for (int i = 0; i < 16; ++i) { const int key = 64 * kt + 32 * kb + (i & 3) + 8 * (i >> 2) + 4 * h; if (key > qpos) sacc[kb][i] = -1e30f; }
                }
                float mx = -1e30f;
#pragma unroll
                for (int kb = 0; kb < 2; ++kb)
#pragma unroll
                    for (int i = 0; i < 16; ++i) mx = fmaxf(mx, sacc[kb][i]);
                mx = fmaxf(mx, __shfl_xor(mx, 32));
                const float m_new = fmaxf(m_run, mx), alpha = fast_exp2((m_run - m_new) * c), mc = m_new * c;
                m_run = m_new; lsum *= alpha;
                if (__builtin_amdgcn_ballot_w64(alpha != 1.0f) != 0ull) {
#pragma unroll
                    for (int d = 0; d < NDB; ++d)
#pragma unroll
                        for (int i = 0; i < 16; ++i) O[d][i] *= alpha;
                }
#pragma unroll
                for (int kb = 0; kb < 2; ++kb)
#pragma unroll
                    for (int i = 0; i < 16; ++i) { const float pv = fast_exp2(sacc[kb][i] * c - mc); lsum += pv; sacc[kb][i] = pv; }
            } else {
#pragma unroll
                for (int kb = 0; kb < 2; ++kb)
#pragma unroll
                    for (int gq = 0; gq < 4; ++gq) {
                        const f32x4 av = *(const f32x4*)(Sl + 32 * kb + 8 * gq + 4 * h);
#pragma unroll
                        for (int e = 0; e < 4; ++e) {
                            const int i = 4 * gq + e; float val = sacc[kb][i] * fast_exp2(av[e] - Mlq);
                            if (diag) { const int key = 64 * kt + 32 * kb + 8 * gq + 4 * h + e; if (key > qpos) val = 0.f; }
                            lsum += val; sacc[kb][i] = val;
                        }
                    }
            }
            bf16x8 P[2][2];
#pragma unroll
            for (int kb = 0; kb < 2; ++kb)
#pragma unroll
                for (int s = 0; s < 2; ++s) { u32x4 pk; pk.x = pack2(sacc[kb][8 * s], sacc[kb][8 * s + 1]); pk.y = pack2(sacc[kb][8 * s + 2], sacc[kb][8 * s + 3]); pk.z = pack2(sacc[kb][8 * s + 4], sacc[kb][8 * s + 5]); pk.w = pack2(sacc[kb][8 * s + 6], sacc[kb][8 * s + 7]); P[kb][s] = __builtin_bit_cast(bf16x8, pk); }
#pragma unroll
            for (int d = 0; d < NDB; ++d)
#pragma unroll
                for (int kb = 0; kb < 2; ++kb)
#pragma unroll
                    for (int s = 0; s < 2; ++s) {
                        const unsigned char* va = Vl + (32 * d + r) * 136 + (32 * kb + 16 * s + 4 * h) * 2;
                        const u32x2 lo = *(const u32x2*)va, hi = *(const u32x2*)(va + 16); u32x4 av; av.x = lo.x; av.y = lo.y; av.z = hi.x; av.w = hi.y;
                        O[d] = MFMA32(__builtin_bit_cast(bf16x8, av), P[kb][s], O[d]);
                    }
        }
    }
#undef AT_LOAD
    lsum += __shfl_xor(lsum, 32);
    if (MODE == 1) {
        const float inv = 1.0f / lsum; bf16_t* yc = (bf16_t*)(p->ws + OFF_YC1) + tq * 1024 + 512 + head * 64;
#pragma unroll
        for (int d = 0; d < NDB; ++d)
#pragma unroll
            for (int gq = 0; gq < 4; ++gq) { u32x2 wv; wv.x = pack2(O[d][4 * gq] * inv, O[d][4 * gq + 1] * inv); wv.y = pack2(O[d][4 * gq + 2] * inv, O[d][4 * gq + 3] * inv); *(u32x2*)(yc + 32 * d + 8 * gq + 4 * h) = wv; }
    } else if (MODE == 2) {
        const float dd = fmaxf(fabsf(lsum), expf(-mtq)), inv = 1.0f / dd; float ss = 0.f;
#pragma unroll
        for (int d = 0; d < NDB; ++d)
#pragma unroll
            for (int i = 0; i < 16; ++i) { O[d][i] *= inv; ss += O[d][i] * O[d][i]; }
        ss += __shfl_xor(ss, 32);
        const float rstd = rsqrtf(ss * (1.0f / 128.0f) + NEPS);
        const bf16_t* og = (const bf16_t*)(p->ws + OFF_P1) + tq * 2048 + 512 + head * 128; const float* gn = p->in[37] + head * 128;
        bf16_t* yc = (bf16_t*)(p->ws + OFF_YC1) + tq * 1024 + head * 128;
#pragma unroll
        for (int d = 0; d < NDB; ++d)
#pragma unroll
            for (int gq = 0; gq < 4; ++gq) {
                const int dv = 32 * d + 8 * gq + 4 * h; const u32x2 ow = *(const u32x2*)(og + dv); const f32x4 gv = *(const f32x4*)(gn + dv);
                const float o0 = O[d][4 * gq] * rstd * gv[0] * sigmoidf_(bflo(ow.x)), o1 = O[d][4 * gq + 1] * rstd * gv[1] * sigmoidf_(bfhi(ow.x));
                const float o2 = O[d][4 * gq + 2] * rstd * gv[2] * sigmoidf_(bflo(ow.y)), o3 = O[d][4 * gq + 3] * rstd * gv[3] * sigmoidf_(bfhi(ow.y));
                u32x2 wv; wv.x = pack2(o0, o1); wv.y = pack2(o2, o3); *(u32x2*)(yc + dv) = wv;
            }
    } else {
        const float inv = 1.0f / lsum; float* X = (float*)ldsb;
        __syncthreads();
        if (g == 1) {
#pragma unroll
            for (int d = 0; d < NDB; ++d)
#pragma unroll
                for (int i = 0; i < 16; ++i) X[(32 * d + (i & 3) + 8 * (i >> 2) + 4 * h) * 128 + 32 * w + r] = O[d][i] * inv;
        }
        __syncthreads();
        if (g == 0) {
            const float lam = ((const float*)(p->ws + OFF_SCAL))[0]; float ss = 0.f;
#pragma unroll
            for (int d = 0; d < NDB; ++d)
#pragma unroll
                for (int i = 0; i < 16; ++i) { const float v = O[d][i] * inv - lam * X[(32 * d + (i & 3) + 8 * (i >> 2) + 4 * h) * 128 + 32 * w + r]; O[d][i] = v; ss += v * v; }
            ss += __shfl_xor(ss, 32);
            const float rstd = rsqrtf(ss * (1.0f / 128.0f) + NEPS) * 0.8f; const float* gn = p->in[11];
            bf16_t* yc = (bf16_t*)(p->ws + OFF_YC0) + tq * 1024 + hp * 128;
#pragma unroll
            for (int d = 0; d < NDB; ++d)
#pragma unroll
                for (int gq = 0; gq < 4; ++gq) {
                    const int dv = 32 * d + 8 * gq + 4 * h; const f32x4 gv = *(const f32x4*)(gn + dv);
                    u32x2 wv; wv.x = pack2(O[d][4 * gq] * rstd * gv[0], O[d][4 * gq + 1] * rstd * gv[1]); wv.y = pack2(O[d][4 * gq + 2] * rstd * gv[2], O[d][4 * gq + 3] * rstd * gv[3]); *(u32x2*)(yc + dv) = wv;
                }
        }
    }
}

DI void s5_consts(KPtr p, int g, int lane, float& ar, float& ai, float (&bbr)[16], float (&bbi)[16]) {
    const float lr = p->in[12][g * 64 + lane], li = p->in[13][g * 64 + lane], dt = expf(p->in[14][g]);
    const float mag = expf(lr * dt); ar = mag * cosf(li * dt); ai = mag * sinf(li * dt);
    const float den = lr * lr + li * li, gr = ((ar - 1.0f) * lr + ai * li) / den, gi = (ai * lr - (ar - 1.0f) * li) / den;
    const f32x4* br4 = (const f32x4*)(p->in[15] + (size_t)(g * 64 + lane) * 16); const f32x4* bi4 = (const f32x4*)(p->in[16] + (size_t)(g * 64 + lane) * 16);
#pragma unroll
    for (int q = 0; q < 4; ++q) { const f32x4 br = br4[q], bi = bi4[q];
#pragma unroll
        for (int e = 0; e < 4; ++e) { bbr[4 * q + e] = gr * br[e] - gi * bi[e]; bbi[4 * q + e] = gr * bi[e] + gi * br[e]; } }
}
#define S5_STEP(tok_) do { const u32x4* up_ = (const u32x4*)(P0 + (size_t)(tok_) * 1536 + 1024 + g * 16); const u32x4 ua_ = up_[0], ub_ = up_[1]; \
        float xr_ = 0.f, xi_ = 0.f; \
        xr_ += bbr[0] * bflo(ua_.x); xi_ += bbi[0] * bflo(ua_.x); xr_ += bbr[1] * bfhi(ua_.x); xi_ += bbi[1] * bfhi(ua_.x); \
        xr_ += bbr[2] * bflo(ua_.y); xi_ += bbi[2] * bflo(ua_.y); xr_ += bbr[3] * bfhi(ua_.y); xi_ += bbi[3] * bfhi(ua_.y); \
        xr_ += bbr[4] * bflo(ua_.z); xi_ += bbi[4] * bflo(ua_.z); xr_ += bbr[5] * bfhi(ua_.z); xi_ += bbi[5] * bfhi(ua_.z); \
        xr_ += bbr[6] * bflo(ua_.w); xi_ += bbi[6] * bflo(ua_.w); xr_ += bbr[7] * bfhi(ua_.w); xi_ += bbi[7] * bfhi(ua_.w); \
        xr_ += bbr[8] * bflo(ub_.x); xi_ += bbi[8] * bflo(ub_.x); xr_ += bbr[9] * bfhi(ub_.x); xi_ += bbi[9] * bfhi(ub_.x); \
        xr_ += bbr[10] * bflo(ub_.y); xi_ += bbi[10] * bflo(ub_.y); xr_ += bbr[11] * bfhi(ub_.y); xi_ += bbi[11] * bfhi(ub_.y); \
        xr_ += bbr[12] * bflo(ub_.z); xi_ += bbi[12] * bflo(ub_.z); xr_ += bbr[13] * bfhi(ub_.z); xi_ += bbi[13] * bfhi(ub_.z); \
        xr_ += bbr[14] * bflo(ub_.w); xi_ += bbi[14] * bflo(ub_.w); xr_ += bbr[15] * bfhi(ub_.w); xi_ += bbi[15] * bfhi(ub_.w); \
        const float nr_ = ar * hr - ai * hi + xr_, ni_ = ar * hi + ai * hr + xi_; hr = nr_; hi = ni_; } while (0)
DI void s5_pass1(KPtr p, int item) {
    const int tid_ = otid(); const int lane = tid_ & 63, wid = tid_ >> 6; const int bg = item >> 2, b = bg >> 5, g = bg & 31, c = (item & 3) * 8 + wid;
    float ar, ai, bbr[16], bbi[16]; s5_consts(p, g, lane, ar, ai, bbr, bbi);
    const bf16_t* P0 = (const bf16_t*)(p->ws + OFF_P0); const int tokb = b * SEQ + c * 128; float hr = 0.f, hi = 0.f;
#pragma unroll 4
    for (int t = 0; t < 128; ++t) S5_STEP(tokb + t);
    f32x2 e; e.x = hr; e.y = hi; ((f32x2*)(p->ws + OFF_S5E))[((size_t)bg * 32 + c) * 64 + lane] = e;
}
DI void s5_pass3(KPtr p, unsigned char* lds, int item) {
    const int tid_ = otid(); const int lane = tid_ & 63, wid = tid_ >> 6; const int bg = item >> 2, b = bg >> 5, g = bg & 31, c = (item & 3) * 8 + wid;
    float ar, ai, bbr[16], bbi[16]; s5_consts(p, g, lane, ar, ai, bbr, bbi);
    float pr = ar, pi = ai;
#pragma unroll
    for (int i = 0; i < 7; ++i) { const float t = pr * pr - pi * pi; pi = 2.0f * pr * pi; pr = t; }
    float hr = 0.f, hi = 0.f; const f32x2* E = (const f32x2*)(p->ws + OFF_S5E) + (size_t)bg * 32 * 64 + lane;
    for (int cc = 0; cc < c; ++cc) { const f32x2 e = E[cc * 64]; const float nr = pr * hr - pi * hi + e.x, ni = pr * hi + pi * hr + e.y; hr = nr; hi = ni; }
    const int hh = lane & 15, quad = lane >> 4;
    bf16x8 cb[4];
#pragma unroll
    for (int ks = 0; ks < 4; ++ks)
#pragma unroll
        for (int j = 0; j < 8; ++j) { const int k = 32 * ks + 8 * quad + j; const float v = k < 64 ? p->in[17][(size_t)(g * 16 + hh) * 64 + k] : -p->in[18][(size_t)(g * 16 + hh) * 64 + (k - 64)]; cb[ks][j] = (short)f2bf(v); }
    const float dsk = p->in[19][g * 16 + hh];
    const bf16_t* P0 = (const bf16_t*)(p->ws + OFF_P0); bf16_t* Z = (bf16_t*)(p->ws + OFF_Z); const int tokb = b * SEQ + c * 128;
    bf16_t* Hs = (bf16_t*)(lds + wid * 4352);
    for (int blk = 0; blk < 8; ++blk) {
#pragma unroll 4
        for (int tt = 0; tt < 16; ++tt) { S5_STEP(tokb + blk * 16 + tt); Hs[tt * 136 + lane] = f2bf(hr); Hs[tt * 136 + 64 + lane] = f2bf(hi); }
        asm volatile("s_waitcnt lgkmcnt(0)" ::: "memory");
        f32x4 acc = {0.f, 0.f, 0.f, 0.f};
#pragma unroll
        for (int ks = 0; ks < 4; ++ks) { const bf16x8 a = *(const bf16x8*)(Hs + hh * 136 + 32 * ks + 8 * quad); acc = MFMA16(a, cb[ks], acc); }
        asm volatile("s_waitcnt lgkmcnt(0)" ::: "memory");
#pragma unroll
        for (int j = 0; j < 4; ++j) {
            const size_t tok = (size_t)tokb + blk * 16 + 4 * quad + j; const float uu = bf2f(P0[tok * 1536 + 1024 + g * 16 + hh]);
            const float y = acc[j] + dsk * uu; const float zz = y * sigmoidf_(1.5957691216057308f * (y + 0.044715f * y * y * y));
            Z[tok * 512 + g * 16 + hh] = f2bf(zz);
        }
    }
}

DI float logsig(float x) { return fminf(x, 0.f) - log1pf(expf(-fabsf(x))); }
DI void phase_l1prep(KPtr p) {
    const int tid = otid(), lane = tid & 63, wid = tid >> 6;
    const bf16_t* P1 = (const bf16_t*)(p->ws + OFF_P1); bf16_t* QK = (bf16_t*)(p->ws + OFF_QKC); const float* G = (const float*)(p->ws + OFF_GATES);
    const int task = blockIdx.x * 8 + wid;
    if (task < 48) {
        const bool ml = task < 16; const int t2 = ml ? task : task - 16; const int b = ml ? (t2 >> 2) : (t2 >> 3), hh = ml ? (t2 & 3) : (t2 & 7);
        const float bfv = ml ? p->in[36][hh] : p->in[38][hh], biv = ml ? p->in[35][hh] : 0.f; const int fcol = ml ? 4 + hh : 8 + hh, icol = hh;
        const size_t base = (size_t)b * SEQ + lane * 64;
        double s = 0.0;
        for (int i = 0; i < 64; ++i) s += (double)logsig(G[(base + i) * 16 + fcol] + bfv);
        double incl = s;
#pragma unroll
        for (int off = 1; off < 64; off <<= 1) { const double t = __shfl_up(incl, off); if (lane >= off) incl += t; }
        const double excl = incl - s;
        if (!ml) {
            float* fF = (float*)(p->ws + OFF_FF) + (size_t)t2 * SEQ + lane * 64; double F = excl;
            for (int i = 0; i < 64; ++i) { F += (double)logsig(G[(base + i) * 16 + fcol] + bfv); fF[i] = (float)F; }
        } else {
            double F = excl; float amax = -3.0e38f;
            for (int i = 0; i < 64; ++i) { F += (double)logsig(G[(base + i) * 16 + fcol] + bfv); const float a = (G[(base + i) * 16 + icol] + biv) - (float)F; amax = fmaxf(amax, a); }
            float pm = amax;
#pragma unroll
            for (int off = 1; off < 64; off <<= 1) { const float t = __shfl_up(pm, off); if (lane >= off) pm = fmaxf(pm, t); }
            float exm = __shfl_up(pm, 1); if (lane == 0) exm = -3.0e38f;
            float Mr = fmaxf(0.f, exm); F = excl;
            float* mA = (float*)(p->ws + OFF_MA) + (size_t)t2 * SEQ + lane * 64; float* mM = (float*)(p->ws + OFF_MM) + (size_t)t2 * SEQ + lane * 64; float* mT = (float*)(p->ws + OFF_MTT) + (size_t)t2 * SEQ + lane * 64;
            for (int i = 0; i < 64; ++i) {
                F += (double)logsig(G[(base + i) * 16 + fcol] + bfv); const float a = (G[(base + i) * 16 + icol] + biv) - (float)F; Mr = fmaxf(Mr, a);
                mA[i] = a * LOG2E; mM[i] = Mr * LOG2E; mT[i] = (float)F + Mr;
            }
        }
    }
    const float* cw = p->in[33]; const float* cbv = p->in[34];
    for (int idx = blockIdx.x * 512 + tid; idx < MT * 64; idx += gridDim.x * 512) {
        const int tok = idx >> 6, c8 = (idx & 63) * 8, pos = tok & (SEQ - 1);
        float acc[8];
#pragma unroll
        for (int e = 0; e < 8; ++e) acc[e] = cbv[c8 + e];
#pragma unroll
        for (int j = 0; j < 4; ++j) {
            if (pos - 3 + j >= 0) {
                const u32x4 xv = *(const u32x4*)(P1 + (size_t)(tok - 3 + j) * 2048 + c8); const f32x4 w0 = *(const f32x4*)(cw + j * 512 + c8), w1 = *(const f32x4*)(cw + j * 512 + c8 + 4);
                acc[0] += w0[0] * bflo(xv.x); acc[1] += w0[1] * bfhi(xv.x); acc[2] += w0[2] * bflo(xv.y); acc[3] += w0[3] * bfhi(xv.y);
                acc[4] += w1[0] * bflo(xv.z); acc[5] += w1[1] * bfhi(xv.z); acc[6] += w1[2] * bflo(xv.w); acc[7] += w1[3] * bfhi(xv.w);
            }
        }
        const float sc = c8 < 256 ? 0.125f : 1.0f;
#pragma unroll
        for (int e = 0; e < 8; ++e) acc[e] = acc[e] * sigmoidf_(acc[e]) * sc;
        u32x4 o; o.x = pack2(acc[0], acc[1]); o.y = pack2(acc[2], acc[3]); o.z = pack2(acc[4], acc[5]); o.w = pack2(acc[6], acc[7]);
        *(u32x4*)(QK + (size_t)tok * 512 + c8) = o;
    }
}

DI void phase_final(KPtr p) {
    const int tid_ = otid(); const int lane = tid_ & 63, wid = tid_ >> 6; const float* ssq = (const float*)(p->ws + OFF_SSQ); const float* gn = p->in[44]; float* out = p->out;
    for (int row = blockIdx.x * 8 + wid; row < MT; row += gridDim.x * 8) {
        float s = lane < 16 ? ssq[(size_t)lane * MT + row] : 0.f;
#pragma unroll
        for (int off = 1; off < 16; off <<= 1) s += __shfl_xor(s, off);
        s = __shfl(s, 0);
        const float rstd = rsqrtf(s * (1.0f / 1024.0f) + NEPS);
#pragma unroll
        for (int i = 0; i < 4; ++i) { const size_t o = (size_t)row * DM + i * 256 + lane * 4; const f32x4 v = *(const f32x4*)(out + o); const f32x4 gv = *(const f32x4*)(gn + i * 256 + lane * 4); *(f32x4*)(out + o) = v * gv * rstd; }
    }
}

#ifdef NO_S5
#define S5P1(...)
#define S5P3(...)
#else
#define S5P1(...) s5_pass1(__VA_ARGS__)
#define S5P3(...) s5_pass3(__VA_ARGS__)
#endif
#ifdef NO_ATT0
#define ATT0(...)
#else
#define ATT0(...) attn_item<0, 128>(__VA_ARGS__)
#endif
#ifdef NO_ATT1
#define ATT1(...)
#else
#define ATT1(...) attn_item<1, 64>(__VA_ARGS__)
#endif
#ifdef NO_ATT2
#define ATT2(...)
#else
#define ATT2(...) attn_item<2, 128>(__VA_ARGS__)
#endif
#ifdef NO_GEMM
#define GEMM(...)
#else
#define GEMM(...) pg8::gemm_phase<__VA_ARGS__
#endif
DI int next_item(unsigned* ctr, unsigned char* lds) {
    volatile int* si = (volatile int*)(lds + LDS_MISC);
    __syncthreads();
    if (threadIdx.x == 0) *si = (int)atomicAdd(ctr, 1u);
    __syncthreads();
    return *si;
}
__global__ void __launch_bounds__(512, 2) fwd_kernel(Params karg) {
    extern __shared__ __attribute__((aligned(16))) unsigned char lds[];
    cg::grid_group grid = cg::this_grid();
#define PH_VARS KPtr p = launder_kp(); PG8_LAS unsigned char* l3 = (PG8_LAS unsigned char*)lds; const int G = osgpr(gridDim.x), c = osgpr(blockIdx.x); unsigned char* ws = p->ws; const char* xb = (const char*)(ws + OFF_XB); float* ssq = (float*)(ws + OFF_SSQ); unsigned* ctr = (unsigned*)(ws + OFF_SCAL) + 8; (void)l3; (void)G; (void)c; (void)xb; (void)ssq; (void)ctr;
    {
        PH_VARS
#ifndef NO_PREP
        phase_prep(p, lds);
#endif
    }
    grid.sync();
    for (int f = 0; f < 4; ++f) {
        {
            PH_VARS
            pg8::Sched2 S{64, 22, 1408, 0, 0, 0, G, c, xb, (const char*)(ws + (size_t)f * SZ_FFN), nullptr, nullptr};
            EpiGateUp E{ssq, (bf16_t*)(ws + OFF_HID)};
#if !defined(ONLY_G) || ONLY_G == 0
            pg8::gemm_phase<EpiGateUp, pg8::Sched2>(l3, 1024, S, E, nullptr);
#endif
        }
        grid.sync();
        {
            PH_VARS
            pg8::Sched2 S{64, 4, 256, 0, 0, 0, G, c, (const char*)(ws + OFF_HID), (const char*)(ws + (size_t)f * SZ_FFN + SZ_WGU), nullptr, nullptr};
            EpiResid E{f == 0 ? p->in[0] : p->out, p->out, (bf16_t*)(ws + OFF_XB), ssq, 0.5f};
#if !defined(ONLY_G) || ONLY_G == 1
            pg8::gemm_phase<EpiResid, pg8::Sched2>(l3, FFH, S, E, nullptr);
#endif
        }
        grid.sync();
        if (f == 0) {
            {
                PH_VARS
                pg8::Sched2 S{64, 6, 384, 2, 64, 128, G, c, xb, (const char*)(ws + OFF_WIN0), (const char*)(ws + OFF_WIN0 + (size_t)1536 * 1024 * 2), xb};
                EpiWin0 E{ssq, (bf16_t*)(ws + OFF_P0), (bf16_t*)(ws + OFF_VT0), (const f32x2*)(ws + OFF_ROPE)};
#if !defined(ONLY_G) || ONLY_G == 2
                pg8::gemm_phase<EpiWin0, pg8::Sched2>(l3, 1024, S, E, nullptr);
#endif
            }
            grid.sync();
            {
                PH_VARS
                for (;;) {
                    const int it = next_item(ctr + 0, lds); if (it >= 1024) break;
                    if (it >= 320 && it < 832) { S5P1(p, it - 320); }
                    else { const int idx = it < 320 ? it : it - 512; const int qblk = 31 - (idx >> 4), bh = idx & 15; ATT0(p, lds, bh >> 2, bh & 3, qblk); }
                }
            }
            grid.sync();
            {
                PH_VARS
                for (int it = c; it < 512; it += G) { S5P3(p, lds, it); }
            }
            grid.sync();
            {
                PH_VARS
                pg8::Sched2 S{64, 2, 128, 0, 0, 0, G, c, (const char*)(ws + OFF_Z), (const char*)(ws + OFF_WGLU), nullptr, nullptr};
                EpiGLU E{(const bf16_t*)(ws + OFF_Z), p->in[21], (bf16_t*)(ws + OFF_YC0)};
#if !defined(ONLY_G) || ONLY_G == 3
                pg8::gemm_phase<EpiGLU, pg8::Sched2>(l3, 512, S, E, nullptr);
#endif
            }
            grid.sync();
        }
        if (f == 2) {
            {
                PH_VARS
                pg8::Sched2 S{64, 9, 576, 4, 64, 256, G, c, xb, (const char*)(ws + OFF_WIN1), (const char*)(ws + OFF_WIN1 + (size_t)2304 * 1024 * 2), xb};
                EpiWin1 E{ssq, (bf16_t*)(ws + OFF_P1), (bf16_t*)(ws + OFF_VT1), (float*)(ws + OFF_GATES)};
#if !defined(ONLY_G) || ONLY_G == 4
                pg8::gemm_phase<EpiWin1, pg8::Sched2>(l3, 1024, S, E, nullptr);
#endif
            }
            grid.sync();
            {
                PH_VARS
#ifndef NO_L1PREP
                phase_l1prep(p);
#endif
            }
            grid.sync();
            {
                PH_VARS
                for (;;) {
                    const int it = next_item(ctr + 1, lds); if (it >= 768) break;
                    const int qblk = 31 - it / 24, r = it % 24;
                    if (r < 8) { ATT2(p, lds, r >> 1, r & 1, qblk); }
                    else { ATT1(p, lds, (r - 8) >> 2, (r - 8) & 3, qblk); }
                }
            }
            grid.sync();
        }
        if (f == 0 || f == 2) {
            PH_VARS
            pg8::Sched2 S{64, 4, 256, 0, 0, 0, G, c, (const char*)(ws + (f == 0 ? OFF_YC0 : OFF_YC1)), (const char*)(ws + (f == 0 ? OFF_WOUT0 : OFF_WOUT1)), nullptr, nullptr};
            EpiResid E{p->out, p->out, (bf16_t*)(ws + OFF_XB), ssq, 1.0f};
#if !defined(ONLY_G) || ONLY_G == 5
            pg8::gemm_phase<EpiResid, pg8::Sched2>(l3, 1024, S, E, nullptr);
#endif
        }
        if (f == 0 || f == 2) grid.sync();
    }
    {
        PH_VARS
        phase_final(p);
    }
}

extern "C" void kernel_launch(void* const* d_in, const int* in_sizes, int n_in, void* d_out, int out_size, void* d_ws, size_t ws_size, hipStream_t stream) {
    static int grid_blocks = 0;
    if (!grid_blocks) {
        int dev = 0, cus = 0, per_cu = 0;
        (void)hipGetDevice(&dev);
        (void)hipDeviceGetAttribute(&cus, hipDeviceAttributeMultiprocessorCount, dev);
        (void)hipFuncSetAttribute((const void*)fwd_kernel, hipFuncAttributeMaxDynamicSharedMemorySize, LDS_BYTES);
        (void)hipOccupancyMaxActiveBlocksPerMultiprocessor(&per_cu, (const void*)fwd_kernel, 512, LDS_BYTES);
        if (per_cu < 1) per_cu = 1;
        grid_blocks = cus * per_cu;
        if (n_in != 45 || ws_size < WS_END) fprintf(stderr, "kernel_launch: unexpected n_in %d / ws %zu\n", n_in, ws_size);
    }
    Params p{};
    for (int i = 0; i < 45; ++i) p.in[i] = (const float*)d_in[i];
    p.out = (float*)d_out; p.ws = (unsigned char*)d_ws;
    for (int i = 0; i < 8; ++i) p.inv_freq[i] = (float)pow(500000.0, -(double)(2 * i) / 16.0);
    void* args[] = {&p};
    hipError_t e = hipLaunchCooperativeKernel((const void*)fwd_kernel, dim3(grid_blocks), dim3(512), args, LDS_BYTES, stream);
    if (e != hipSuccess) fprintf(stderr, "cooperative launch failed: %s (grid %d)\n", hipGetErrorString(e), grid_blocks);
}
```

```cpp
#include <hip/hip_runtime.h>
#include <hip/hip_cooperative_groups.h>
#include <cstdio>
#include <cmath>
namespace cg = cooperative_groups;

#define PG8_LAS __attribute__((address_space(3)))
#define DI __device__ __forceinline__
typedef unsigned short bf16_t;
typedef short bf16x8 __attribute__((ext_vector_type(8)));
typedef float f32x4 __attribute__((ext_vector_type(4)));
typedef float f32x2 __attribute__((ext_vector_type(2)));
typedef float f32x16 __attribute__((ext_vector_type(16)));
typedef unsigned u32x4 __attribute__((ext_vector_type(4)));
typedef unsigned u32x2 __attribute__((ext_vector_type(2)));
typedef __bf16 bf16x2n __attribute__((ext_vector_type(2)));

constexpr int MT = 16384, DM = 1024, SEQ = 4096, FFH = 2816;
constexpr float LOG2E = 1.4426950408889634f;
constexpr float NEPS = 1e-6f;

constexpr size_t SZ_WGU = (size_t)5632 * 1024 * 2, SZ_WD = (size_t)1024 * 2816 * 2, SZ_FFN = SZ_WGU + SZ_WD;
constexpr size_t OFF_WIN0 = 4 * SZ_FFN;
constexpr size_t OFF_WGLU = OFF_WIN0 + (size_t)2048 * 1024 * 2;
constexpr size_t OFF_WOUT0 = OFF_WGLU + (size_t)512 * 512 * 2;
constexpr size_t OFF_WIN1 = OFF_WOUT0 + (size_t)1024 * 1024 * 2;
constexpr size_t OFF_WOUT1 = OFF_WIN1 + (size_t)3328 * 1024 * 2;
constexpr size_t OFF_XB = OFF_WOUT1 + (size_t)1024 * 1024 * 2;
constexpr size_t OFF_SSQ = OFF_XB + (size_t)MT * 1024 * 2;
constexpr size_t OFF_ROPE = OFF_SSQ + (size_t)16 * MT * 4;
constexpr size_t OFF_GATES = OFF_ROPE + (size_t)4096 * 8 * 8;
constexpr size_t OFF_MA = OFF_GATES + (size_t)MT * 16 * 4;
constexpr size_t OFF_MM = OFF_MA + (size_t)16 * 4096 * 4;
constexpr size_t OFF_MTT = OFF_MM + (size_t)16 * 4096 * 4;
constexpr size_t OFF_FF = OFF_MTT + (size_t)16 * 4096 * 4;
constexpr size_t OFF_S5E = OFF_FF + (size_t)32 * 4096 * 4;
constexpr size_t OFF_SCAL = OFF_S5E + (size_t)128 * 32 * 64 * 8;
constexpr size_t OFF_BAR = OFF_SCAL + 256;
constexpr size_t BAR_BYTES = 16384;
constexpr size_t OFF_U = OFF_BAR + BAR_BYTES;
constexpr size_t OFF_HID = OFF_U;
constexpr size_t OFF_P0 = OFF_U, OFF_VT0 = OFF_P0 + (size_t)MT * 1536 * 2, OFF_YC0 = OFF_VT0 + (size_t)512 * MT * 2, OFF_Z = OFF_YC0 + (size_t)MT * 1024 * 2;
constexpr size_t OFF_P1 = OFF_U, OFF_VT1 = OFF_P1 + (size_t)MT * 2048 * 2, OFF_YC1 = OFF_VT1 + (size_t)1024 * MT * 2;
constexpr size_t WS_END = OFF_YC1 + (size_t)MT * 1024 * 2;
static_assert(WS_END <= (size_t)256 * 1024 * 1024, "workspace");
static_assert(OFF_Z + (size_t)MT * 512 * 2 <= WS_END, "workspace L0");

constexpr int LDS_BYTES = 131072 + 1024 + 4352;
constexpr int LDS_RSTD = 131072 + 1024;
constexpr int LDS_MISC = 131072;

struct Params { const float* in[45]; float* out; unsigned char* ws; float inv_freq[8]; };
typedef const __attribute__((address_space(4))) Params* KPtr;
DI int otid() { int t = threadIdx.x; asm volatile("" : "+v"(t)); return t; }
DI int osgpr(int v) { asm volatile("" : "+s"(v)); return v; }
DI KPtr launder_kp() { KPtr q = (KPtr)__builtin_amdgcn_kernarg_segment_ptr(); asm volatile("" : "+s"(q)); return q; }

DI bf16_t f2bf(float f) { unsigned u = __float_as_uint(f); u += 0x7fffu + ((u >> 16) & 1u); return (bf16_t)(u >> 16); }
DI float bf2f(bf16_t b) { return __uint_as_float(((unsigned)b) << 16); }
DI unsigned pack2(float a, float b) { f32x2 v = {a, b}; bf16x2n r = __builtin_convertvector(v, bf16x2n); return __builtin_bit_cast(unsigned, r); }
DI float bflo(unsigned w) { return __uint_as_float(w << 16); }
DI float bfhi(unsigned w) { return __uint_as_float(w & 0xffff0000u); }
DI float fast_rcp(float x) { return __builtin_amdgcn_rcpf(x); }
DI float fast_exp2(float x) { return __builtin_amdgcn_exp2f(x); }
DI float sigmoidf_(float x) { return fast_rcp(1.0f + __expf(-x)); }

namespace pg8 {
constexpr int BM = 256, BK = 64, HALF = 128, HTB = HALF * BK * 2, STAGE_BYTES = 8 * HTB, NXCD = 8, WGM = 8;
__host__ __device__ __forceinline__ int lds_byte(int r, int c) { const int st = (r >> 4) * 2 + (c >> 5), rr = r & 15, cc = c & 31, ob = rr * 64 + cc * 2; return st * 1024 + (ob ^ (((ob >> 9) & 1) << 5)); }
__host__ __device__ __forceinline__ void stage_rc(int b, int& R, int& C) { const int st = b / 1024, sb = b % 1024, swz = sb ^ (((sb >> 9) & 1) << 5); R = (st >> 1) * 16 + swz / 64; C = (st & 1) * 32 + (swz % 64) / 2; }
__host__ __device__ __forceinline__ int perm32(int rho) { const int n = rho >> 4, i = rho & 15; return 8 * (i >> 2) + 4 * n + (i & 3); }
struct Unit { int pm, pn, kind; };
DI void decode_unit(int L, int nM, int nN, int& pm, int& pn) {
    const int nwg = nM * nN; int wgid = L; { const int q = nwg / NXCD, r = nwg % NXCD, xcd = wgid % NXCD, off = wgid / NXCD; wgid = (xcd < r ? xcd * (q + 1) : r * (q + 1) + (xcd - r) * q) + off; }
    const int nig = WGM * nN, gid = wgid / nig, fm = gid * WGM, gsz = (nM - fm) < WGM ? (nM - fm) : WGM;
    pm = fm + ((wgid % nig) % gsz); pn = (wgid % nig) / gsz;
}
struct Sched2 {
    int n1M, n1N, n1, n2M, n2N, n2, G, c; const char *A1, *B1, *A2, *B2;
    DI bool next(int i, Unit& u) const {
        long L = (long)i * G + c;
        if (L < n1) { decode_unit((int)L, n1M, n1N, u.pm, u.pn); u.kind = 0; return true; }
        L -= n1;
        if (L < n2) { decode_unit((int)L, n2M, n2N, u.pm, u.pn); u.kind = 1; return true; }
        return false;
    }
    DI const char* aptr(const Unit& u, size_t tstep) const { return (u.kind ? A2 : A1) + (size_t)u.pm * tstep; }
    DI const char* bptr(const Unit& u, size_t tstep) const { return (u.kind ? B2 : B1) + (size_t)u.pn * tstep; }
    DI void a_ready(const Unit&) const {}
    DI void done(const Unit&) const {}
};
DI long long wall_clock64_() { return 0; }
#define wall_clock64 wall_clock64_
template <class Epi, class Sched, bool STAMP = false>
__device__ __forceinline__ void gemm_phase(PG8_LAS unsigned char* lds, const int Kdim, const Sched& S, const Epi& E, unsigned long long* stamps) {
    const int tid = otid(), wid = __builtin_amdgcn_readfirstlane(tid >> 6), lane = tid & 63, wr = wid >> 2, wc = wid & 3, fr = lane & 15, fq = lane >> 4;
    const int K = Kdim, nt = K / BK;
    int ts_lo = 0, ts_hi = 0, nts = 0; const unsigned long long rt_entry = STAMP ? (unsigned long long)wall_clock64() : 0ull;
#define PG8_STAMP() do { if (STAMP && wid == 0 && nts < 64) { const unsigned long long _c = (unsigned long long)clock64(); \
        ts_lo = (lane == nts) ? (int)(unsigned)_c : ts_lo; ts_hi = (lane == nts) ? (int)(unsigned)(_c >> 32) : ts_hi; ++nts; } } while (0)
    PG8_STAMP();
    unsigned voffA[2], voffB[2];
#pragma unroll
    for (int i = 0; i < 2; ++i) { int R, C; stage_rc(tid * 16 + i * 8192, R, C); const int Rb = Epi::PERM ? ((R & ~31) + perm32(R & 31)) : R;
        voffA[i] = (unsigned)(R * K + C) * 2u; voffB[i] = (unsigned)(Rb * K + C) * 2u; }
    const size_t kstep = (size_t)(BK * 2);
    const size_t hstep = (size_t)HALF * K * 2;
    const size_t tstep = 2 * hstep;
    const unsigned ldsw = (unsigned)wid * 1024u;
    const int aoff = lds_byte(wr * 64 + fr, fq * 8), boff = lds_byte(wc * 32 + fr, fq * 8);
#define PG8_SA(b, h) (((b) * 2 + (h)) * HTB)
#define PG8_SB(b, h) ((4 + (b) * 2 + (h)) * HTB)
#define PG8_STAGE(bufoff, gbase, voff) do { _Pragma("unroll") for (int _i = 0; _i < 2; ++_i) \
        __builtin_amdgcn_global_load_lds((const unsigned*)((const char*)(gbase) + (voff)[_i]), (PG8_LAS unsigned*)(lds + (bufoff) + ldsw + _i * 8192), 16, 0, 0); } while (0)
#define PG8_LDA(dst, b, h) do { _Pragma("unroll") for (int m = 0; m < 4; ++m) _Pragma("unroll") for (int k = 0; k < 2; ++k) dst[m][k] = *(const PG8_LAS bf16x8*)(lds + PG8_SA(b, h) + aoff + m * 2048 + k * 1024); } while (0)
#define PG8_LDB(dst, b, h) do { _Pragma("unroll") for (int n = 0; n < 2; ++n) _Pragma("unroll") for (int k = 0; k < 2; ++k) dst[n][k] = *(const PG8_LAS bf16x8*)(lds + PG8_SB(b, h) + boff + n * 2048 + k * 1024); } while (0)
#define PG8_MMA(ai, bj, At, Bt) do { __builtin_amdgcn_s_setprio(1); _Pragma("unroll") for (int m = 0; m < 4; ++m) _Pragma("unroll") for (int n = 0; n < 2; ++n) _Pragma("unroll") for (int k = 0; k < 2; ++k) \
        acc[ai][bj][m][n] = __builtin_amdgcn_mfma_f32_16x16x32_bf16(Bt[n][k], At[m][k], acc[ai][bj][m][n], 0, 0, 0); __builtin_amdgcn_s_setprio(0); } while (0)
#define PG8_WAIT_V(n) asm volatile("s_waitcnt vmcnt(" #n ")" ::: "memory")
#define PG8_WAIT_L(n) asm volatile("s_waitcnt lgkmcnt(" #n ")" ::: "memory")
#define PG8_BAR __builtin_amdgcn_s_barrier()
#define PG8_SCHED __builtin_amdgcn_sched_barrier(0)
    Unit cur, nxt; int ui = 0;
    if (!S.next(0, cur)) return;
    f32x4 acc[2][2][4][2];
#pragma unroll
    for (int a = 0; a < 2; ++a)
#pragma unroll
        for (int b = 0; b < 2; ++b)
#pragma unroll
            for (int m = 0; m < 4; ++m)
#pragma unroll
                for (int n = 0; n < 2; ++n) acc[a][b][m][n] = (f32x4){0.f, 0.f, 0.f, 0.f};
    bf16x8 At[4][2], B0[2][2], B1[2][2];
    const char* cA = S.aptr(cur, tstep); const char* cB = S.bptr(cur, tstep);
    S.a_ready(cur);
    PG8_STAGE(PG8_SB(0, 0), cB, voffB); PG8_STAGE(PG8_SA(0, 0), cA, voffA); PG8_STAGE(PG8_SB(0, 1), cB + hstep, voffB); PG8_STAGE(PG8_SA(0, 1), cA + hstep, voffA);
    if (wr == 1) PG8_BAR;
    PG8_WAIT_V(4); PG8_BAR;
    PG8_STAGE(PG8_SB(1, 0), cB + kstep, voffB); PG8_STAGE(PG8_SA(1, 0), cA + kstep, voffA); PG8_STAGE(PG8_SB(1, 1), cB + hstep + kstep, voffB);
    PG8_WAIT_V(6); PG8_BAR;
    PG8_STAMP();
    for (;;) {
        const bool has_next = S.next(ui + 1, nxt);
        const char* nA = has_next ? S.aptr(nxt, tstep) : cA; const char* nB = has_next ? S.bptr(nxt, tstep) : cB;
        for (int t = 0; t < nt; t += 2) {
            const bool last = (t == nt - 2);
            const char* a1 = cA + (size_t)(t + 1) * kstep;
            const char* a2 = last ? nA : cA + (size_t)(t + 2) * kstep; const char* b2 = last ? nB : cB + (size_t)(t + 2) * kstep;
            const char* a3 = a2 + kstep; const char* b3 = b2 + kstep;
            if (last && has_next) S.a_ready(nxt);
            PG8_LDB(B0, 0, 0); PG8_SCHED; PG8_LDA(At, 0, 0); PG8_STAGE(PG8_SA(1, 1), a1 + hstep, voffA);
            PG8_WAIT_L(8); PG8_BAR; PG8_WAIT_L(0); PG8_MMA(0, 0, At, B0); PG8_BAR; PG8_SCHED;
            PG8_LDB(B1, 0, 1); PG8_STAGE(PG8_SB(0, 0), b2, voffB);
            PG8_BAR; PG8_WAIT_L(0); PG8_MMA(0, 1, At, B1); PG8_BAR;
            PG8_LDA(At, 0, 1); PG8_STAGE(PG8_SA(0, 0), a2, voffA);
            PG8_BAR; PG8_WAIT_L(0); PG8_MMA(1, 0, At, B0); PG8_BAR; PG8_SCHED;
            PG8_STAGE(PG8_SB(0, 1), b2 + hstep, voffB);
            PG8_WAIT_V(6); PG8_BAR; PG8_MMA(1, 1, At, B1); PG8_BAR;
            PG8_LDB(B0, 1, 0); PG8_SCHED; PG8_LDA(At, 1, 0); PG8_STAGE(PG8_SA(0, 1), a2 + hstep, voffA);
            PG8_WAIT_L(8); PG8_BAR; PG8_WAIT_L(0); PG8_MMA(0, 0, At, B0); PG8_BAR; PG8_SCHED;
            PG8_LDB(B1, 1, 1); PG8_STAGE(PG8_SB(1, 0), b3, voffB);
            PG8_BAR; PG8_WAIT_L(0); PG8_MMA(0, 1, At, B1); PG8_BAR;
            PG8_LDA(At, 1, 1); PG8_STAGE(PG8_SA(1, 0), a3, voffA);
            PG8_BAR; PG8_WAIT_L(0); PG8_MMA(1, 0, At, B0); PG8_BAR; PG8_SCHED;
            PG8_STAGE(PG8_SB(1, 1), b3 + hstep, voffB);
            PG8_WAIT_V(6); PG8_BAR; PG8_MMA(1, 1, At, B1); PG8_BAR;
        }
        PG8_STAMP();
        if constexpr (!Epi::AFTER_DRAIN) { E(acc, cur, wr, wc, fr, fq); S.done(cur); }
        PG8_STAMP();
        if (!has_next) break;
#pragma unroll
        for (int a = 0; a < 2; ++a)
#pragma unroll
            for (int b = 0; b < 2; ++b)
#pragma unroll
                for (int m = 0; m < 4; ++m)
#pragma unroll
                    for (int n = 0; n < 2; ++n) acc[a][b][m][n] = (f32x4){0.f, 0.f, 0.f, 0.f};
        cur = nxt; cA = nA; cB = nB; ++ui;
    }
    PG8_WAIT_V(0);
    if (wr == 0) PG8_BAR;
    PG8_BAR;
    if constexpr (Epi::AFTER_DRAIN) { E.fused(acc, cur, wr, wc, fr, fq, lds, wid, lane); S.done(cur); }
    PG8_STAMP();
    if (STAMP && wid == 0) { stamps[lane] = lane < nts ? (((unsigned long long)(unsigned)ts_hi << 32) | (unsigned)ts_lo) : 0ull;
        if (lane == 62) stamps[62] = rt_entry; if (lane == 63) stamps[63] = (unsigned long long)wall_clock64(); }
#undef PG8_STAMP
#undef PG8_SA
#undef PG8_SB
#undef PG8_STAGE
#undef PG8_LDA
#undef PG8_LDB
#undef PG8_MMA
#undef PG8_WAIT_V
#undef PG8_WAIT_L
#undef PG8_BAR
#undef PG8_SCHED
}
#undef wall_clock64
}
using pg8::Unit;
typedef f32x4 AccT[2][2][4][2];

DI void row_rstd(const float* ssq, int row0, int fq, float (&rs)[2][4]) {
#pragma unroll
    for (int ai = 0; ai < 2; ++ai)
#pragma unroll
        for (int m = 0; m < 4; ++m) {
            const int row = row0 + ai * 128 + m * 16; float s = 0.f;
#pragma unroll
            for (int q = 0; q < 4; ++q) s += ssq[(size_t)(4 * fq + q) * MT + row];
            s += __shfl_xor(s, 16); s += __shfl_xor(s, 32);
            rs[ai][m] = rsqrtf(s * (1.0f / 1024.0f) + NEPS);
        }
}
DI void row_rstd_cached(const float* ssq, int tag, int row0, int wave, int fr, int fq, float (&rs)[2][4]) {
    PG8_LAS float* tab = (PG8_LAS float*)(unsigned)(LDS_RSTD + wave * 544); volatile PG8_LAS int* tagp = (volatile PG8_LAS int*)(unsigned)(LDS_RSTD + wave * 544 + 512);
    if (*tagp != tag) {
#pragma unroll
        for (int ai = 0; ai < 2; ++ai)
#pragma unroll
            for (int m = 0; m < 4; ++m) {
                const int row = row0 + ai * 128 + m * 16; float sq = 0.f;
#pragma unroll
                for (int q = 0; q < 4; ++q) sq += ssq[(size_t)(4 * fq + q) * MT + row];
                sq += __shfl_xor(sq, 16); sq += __shfl_xor(sq, 32);
                if (fq == 0) tab[(ai * 4 + m) * 16 + fr] = rsqrtf(sq * (1.0f / 1024.0f) + NEPS);
            }
        if (fr == 0 && fq == 0) *tagp = tag;
        asm volatile("s_waitcnt lgkmcnt(0)" ::: "memory");
    }
#pragma unroll
    for (int ai = 0; ai < 2; ++ai)
#pragma unroll
        for (int m = 0; m < 4; ++m) rs[ai][m] = tab[(ai * 4 + m) * 16 + fr];
}
DI void rstd_cache_reset() { const int t = otid(); if ((t & 63) == 0) *(volatile PG8_LAS int*)(unsigned)(LDS_RSTD + (t >> 6) * 544 + 512) = -1; }
DI u32x4 pack8(const f32x4& a, const f32x4& b) { u32x4 w; w.x = pack2(a[0], a[1]); w.y = pack2(a[2], a[3]); w.z = pack2(b[0], b[1]); w.w = pack2(b[2], b[3]); return w; }
DI void epi_vt(const AccT& acc, const Unit& u, int wr, int wc, int fr, int fq, const float* ssq, bf16_t* vt) {
    const int tokb = u.pn * 256 + wc * 32 + 8 * fq;
    f32x4 rt[2][2];
#pragma unroll
    for (int bj = 0; bj < 2; ++bj)
#pragma unroll
        for (int n = 0; n < 2; ++n) {
            f32x4 s = *(const f32x4*)(ssq + (size_t)fr * MT + tokb + bj * 128 + n * 4);
#pragma unroll
            for (int off = 1; off < 16; off <<= 1) { s[0] += __shfl_xor(s[0], off); s[1] += __shfl_xor(s[1], off); s[2] += __shfl_xor(s[2], off); s[3] += __shfl_xor(s[3], off); }
#pragma unroll
            for (int j = 0; j < 4; ++j) s[j] = rsqrtf(s[j] * (1.0f / 1024.0f) + NEPS);
            rt[bj][n] = s;
        }
#pragma unroll
    for (int ai = 0; ai < 2; ++ai)
#pragma unroll
        for (int m = 0; m < 4; ++m) {
            const int row = u.pm * 256 + ai * 128 + wr * 64 + m * 16 + fr;
#pragma unroll
            for (int bj = 0; bj < 2; ++bj) {
                const f32x4 v0 = acc[ai][bj][m][0] * rt[bj][0], v1 = acc[ai][bj][m][1] * rt[bj][1];
                *(u32x4*)(vt + (size_t)row * MT + tokb + bj * 128) = pack8(v0, v1);
            }
        }
}

struct EpiGateUp {
    static constexpr bool PERM = true, AFTER_DRAIN = false;
    const float* ssq; bf16_t* hid;
    DI void operator()(const AccT& acc, const Unit& u, int wr, int wc, int fr, int fq) const {
        const int row0 = u.pm * 256 + wr * 64 + fr; float rs[2][4]; row_rstd_cached(ssq, u.pm, row0, wr * 4 + wc, fr, fq, rs);
        const int colh = u.pn * 128 + wc * 32 + 8 * fq;
#pragma unroll
        for (int ai = 0; ai < 2; ++ai)
#pragma unroll
            for (int m = 0; m < 4; ++m) {
                const float r = rs[ai][m]; f32x4 h0, h1;
#pragma unroll
                for (int j = 0; j < 4; ++j) {
                    const float g0 = acc[ai][0][m][0][j] * r, g1 = acc[ai][0][m][1][j] * r, u0 = acc[ai][1][m][0][j] * r, u1 = acc[ai][1][m][1][j] * r;
                    h0[j] = g0 * sigmoidf_(g0) * u0; h1[j] = g1 * sigmoidf_(g1) * u1;
                }
                *(u32x4*)(hid + (size_t)(row0 + ai * 128 + m * 16) * FFH + colh) = pack8(h0, h1);
            }
    }
};
struct EpiResid {
    static constexpr bool PERM = false, AFTER_DRAIN = false;
    const float* xin32; bf16_t* xb; float* ssq; float scale;
    DI void operator()(const AccT& acc, const Unit& u, int wr, int wc, int fr, int fq) const {
        const int row0 = u.pm * 256 + wr * 64 + fr, col0 = u.pn * 256 + wc * 32 + 4 * fq;
#pragma unroll
        for (int ai = 0; ai < 2; ++ai)
#pragma unroll
            for (int m = 0; m < 4; ++m) {
                const int row = row0 + ai * 128 + m * 16; float ss = 0.f;
#pragma unroll
                for (int bj = 0; bj < 2; ++bj)
#pragma unroll
                    for (int n = 0; n < 2; ++n) {
                        const size_t o = (size_t)row * DM + col0 + bj * 128 + n * 16;
                        f32x4 xr;
                        if (xin32) xr = *(const f32x4*)(xin32 + o);
                        else { const u32x2 w0 = *(const u32x2*)(xb + o); xr[0] = bflo(w0.x); xr[1] = bfhi(w0.x); xr[2] = bflo(w0.y); xr[3] = bfhi(w0.y); }
                        const f32x4 xn = xr + acc[ai][bj][m][n] * scale;
                        u32x2 w; w.x = pack2(xn[0], xn[1]); w.y = pack2(xn[2], xn[3]); *(u32x2*)(xb + o) = w;
                        ss += (xn[0] * xn[0] + xn[1] * xn[1]) + (xn[2] * xn[2] + xn[3] * xn[3]);
                    }
                ss += __shfl_xor(ss, 16); ss += __shfl_xor(ss, 32);
                if (fq == 0) ssq[(size_t)(4 * u.pn + wc) * MT + row] = ss;
            }
    }
};
struct EpiWin0 {
    static constexpr bool PERM = true, AFTER_DRAIN = false;
    const float* ssq; bf16_t* p0; bf16_t* vt; const f32x2* rope;
    DI void operator()(const AccT& acc, const Unit& u, int wr, int wc, int fr, int fq) const {
        if (u.kind) { epi_vt(acc, u, wr, wc, fr, fq, ssq, vt); return; }
        const int row0 = u.pm * 256 + wr * 64 + fr; float rs[2][4]; row_rstd_cached(ssq, u.pm, row0, wr * 4 + wc, fr, fq, rs);
        const bool rot = (u.pn < 4) && !(wc & 1) && (fq < 2);
#pragma unroll
        for (int ai = 0; ai < 2; ++ai)
#pragma unroll
            for (int m = 0; m < 4; ++m) {
                const int row = row0 + ai * 128 + m * 16; const float r = rs[ai][m]; const int pos = row & (SEQ - 1);
#pragma unroll
                for (int bj = 0; bj < 2; ++bj) {
                    f32x4 v0 = acc[ai][bj][m][0] * r, v1 = acc[ai][bj][m][1] * r;
                    if (rot) {
                        const f32x2* tb = rope + pos * 8 + 4 * fq;
#pragma unroll
                        for (int j = 0; j < 4; ++j) { const f32x2 cs = tb[j]; const float x1 = v0[j], x2 = v1[j]; v0[j] = x1 * cs.x - x2 * cs.y; v1[j] = x2 * cs.x + x1 * cs.y; }
                    }
                    *(u32x4*)(p0 + (size_t)row * 1536 + u.pn * 256 + bj * 128 + wc * 32 + 8 * fq) = pack8(v0, v1);
                }
            }
    }
};
struct EpiWin1 {
    static constexpr bool PERM = true, AFTER_DRAIN = false;
    const float* ssq; bf16_t* p1; bf16_t* vt; float* gates;
    DI void operator()(const AccT& acc, const Unit& u, int wr, int wc, int fr, int fq) const {
        if (u.kind) { epi_vt(acc, u, wr, wc, fr, fq, ssq, vt); return; }
        const int row0 = u.pm * 256 + wr * 64 + fr; float rs[2][4]; row_rstd_cached(ssq, u.pm, row0, wr * 4 + wc, fr, fq, rs);
#pragma unroll
        for (int ai = 0; ai < 2; ++ai)
#pragma unroll
            for (int m = 0; m < 4; ++m) {
                const int row = row0 + ai * 128 + m * 16; const float r = rs[ai][m];
                if (u.pn < 8) {
#pragma unroll
                    for (int bj = 0; bj < 2; ++bj) {
                        const f32x4 v0 = acc[ai][bj][m][0] * r, v1 = acc[ai][bj][m][1] * r;
                        *(u32x4*)(p1 + (size_t)row * 2048 + u.pn * 256 + bj * 128 + wc * 32 + 8 * fq) = pack8(v0, v1);
                    }
                } else if (wc == 0 && fq < 2) {
                    *(f32x4*)(gates + (size_t)row * 16 + 8 * fq) = acc[ai][0][m][0] * r;
                    *(f32x4*)(gates + (size_t)row * 16 + 8 * fq + 4) = acc[ai][0][m][1] * r;
                }
            }
    }
};
struct EpiGLU {
    static constexpr bool PERM = true, AFTER_DRAIN = false;
    const bf16_t* z; const float* bias; bf16_t* ycat;
    DI void operator()(const AccT& acc, const Unit& u, int wr, int wc, int fr, int fq) const {
        const int row0 = u.pm * 256 + wr * 64 + fr, colb = u.pn * 256 + wc * 32 + 8 * fq;
#pragma unroll
        for (int bj = 0; bj < 2; ++bj) {
            const int col = colb + bj * 128;
            const f32x4 b0 = *(const f32x4*)(bias + col), b1 = *(const f32x4*)(bias + col + 4);
#pragma unroll
            for (int ai = 0; ai < 2; ++ai)
#pragma unroll
                for (int m = 0; m < 4; ++m) {
                    const int row = row0 + ai * 128 + m * 16;
                    const u32x4 zz = *(const u32x4*)(z + (size_t)row * 512 + col);
                    const f32x4 g0 = acc[ai][bj][m][0] + b0, g1 = acc[ai][bj][m][1] + b1; f32x4 o0, o1;
                    o0[0] = bflo(zz.x) * sigmoidf_(g0[0]); o0[1] = bfhi(zz.x) * sigmoidf_(g0[1]); o0[2] = bflo(zz.y) * sigmoidf_(g0[2]); o0[3] = bfhi(zz.y) * sigmoidf_(g0[3]);
                    o1[0] = bflo(zz.z) * sigmoidf_(g1[0]); o1[1] = bfhi(zz.z) * sigmoidf_(g1[1]); o1[2] = bflo(zz.w) * sigmoidf_(g1[2]); o1[3] = bfhi(zz.w) * sigmoidf_(g1[3]);
                    *(u32x4*)(ycat + (size_t)row * 1024 + 512 + col) = pack8(o0, o1);
                }
        }
    }
};

struct Job { const float* W; const float* W2; const float* gain; bf16_t* dst; int K, ldw, nrows, kind; };
DI int ffn_base(int f) { return f == 0 ? 1 : (f == 1 ? 23 : (f == 2 ? 27 : 40)); }
DI Job get_job(KPtr p, int j) {
    Job J; J.W2 = nullptr; J.gain = nullptr; J.kind = 0;
    if (j < 4) { const int nb = ffn_base(j); J.W = p->in[nb + 1]; J.W2 = p->in[nb + 2]; J.gain = p->in[nb]; J.dst = (bf16_t*)(p->ws + (size_t)j * SZ_FFN); J.K = 1024; J.ldw = FFH; J.nrows = 5632; J.kind = 1; }
    else if (j < 8) { const int nb = ffn_base(j - 4); J.W = p->in[nb + 3]; J.dst = (bf16_t*)(p->ws + (size_t)(j - 4) * SZ_FFN + SZ_WGU); J.K = FFH; J.ldw = 1024; J.nrows = 1024; }
    else if (j == 8) { J.W = p->in[6]; J.gain = p->in[5]; J.dst = (bf16_t*)(p->ws + OFF_WIN0); J.K = 1024; J.ldw = 2048; J.nrows = 2048; J.kind = 2; }
    else if (j == 9) { J.W = p->in[20]; J.dst = (bf16_t*)(p->ws + OFF_WGLU); J.K = 512; J.ldw = 512; J.nrows = 512; }
    else if (j == 10) { J.W = p->in[22]; J.dst = (bf16_t*)(p->ws + OFF_WOUT0); J.K = 1024; J.ldw = 1024; J.nrows = 1024; }
    else if (j == 11) { J.W = p->in[32]; J.gain = p->in[31]; J.dst = (bf16_t*)(p->ws + OFF_WIN1); J.K = 1024; J.ldw = 3088; J.nrows = 3328; J.kind = 3; }
    else { J.W = p->in[39]; J.dst = (bf16_t*)(p->ws + OFF_WOUT1); J.K = 1024; J.ldw = 1024; J.nrows = 1024; }
    return J;
}
DI int job_tiles(int j) { return j < 4 ? 176 : (j < 8 ? 88 : (j == 8 ? 64 : (j == 9 ? 8 : (j == 11 ? 104 : 32)))); }
DI int map_col(int kind, int n, bool& w2) {
    w2 = false;
    if (kind == 0) return n;
    if (kind == 1) { w2 = (n >> 7) & 1; return (n >> 8) * 128 + (n & 127); }
    if (kind == 2) {
        if (n < 1024) { const int pos = n & 63, base = n - pos; int lg = pos; if (pos < 16) lg = pos < 8 ? (pos < 4 ? pos : pos + 4) : (pos < 12 ? pos - 4 : pos); return base + lg; }
        if (n < 1536) return 1536 + (n - 1024);
        return 1024 + (n - 1536);
    }
    if (n < 512) return n;
    if (n < 1024) return 1032 + (n - 512);
    if (n < 1536) return 1544 + (n - 1024);
    if (n < 2048) return 2056 + (n - 1536);
    if (n < 2304) { const int j = n - 2048; return j < 4 ? 1024 : (j < 8 ? 1028 : (j < 16 ? 3080 + (j - 8) : -1)); }
    if (n < 2816) return 512 + (n - 2304);
    return 2568 + (n - 2816);
}
DI void phase_prep(KPtr p, unsigned char* lds) {
    const int tid = otid(), lane = tid & 63, wid = tid >> 6;
    if (blockIdx.x == 0 && wid == 0) {
        float s1 = p->in[7][lane] * p->in[8][lane], s2 = p->in[9][lane] * p->in[10][lane];
#pragma unroll
        for (int off = 1; off < 64; off <<= 1) { s1 += __shfl_xor(s1, off); s2 += __shfl_xor(s2, off); }
        if (lane == 0) { float* sc = (float*)(p->ws + OFF_SCAL); sc[0] = expf(s1) - expf(s2) + 0.2f; }
        if (lane < 48) ((unsigned*)(p->ws + OFF_SCAL) + 8)[lane] = 0u;
    }
    for (int idx = blockIdx.x * 512 + tid; idx < 4096 * 8; idx += gridDim.x * 512) {
        const int pos = idx >> 3, i = idx & 7; float fi = p->inv_freq[0];
        fi = i == 1 ? p->inv_freq[1] : fi; fi = i == 2 ? p->inv_freq[2] : fi; fi = i == 3 ? p->inv_freq[3] : fi; fi = i == 4 ? p->inv_freq[4] : fi; fi = i == 5 ? p->inv_freq[5] : fi; fi = i == 6 ? p->inv_freq[6] : fi; fi = i == 7 ? p->inv_freq[7] : fi;
        const float angf = (float)pos * fi; const double a = (double)angf; const double kk = rint(a * 0.15915494309189535); const double r = a - kk * 6.283185307179586;
        const float fr = (float)(r * 0.15915494309189535);
        f32x2 cs; cs.x = __builtin_amdgcn_cosf(fr); cs.y = __builtin_amdgcn_sinf(fr);
        ((f32x2*)(p->ws + OFF_ROPE))[idx] = cs;
    }
    {
        const float* x = p->in[0]; bf16_t* xb = (bf16_t*)(p->ws + OFF_XB); float* ssq = (float*)(p->ws + OFF_SSQ);
        const int rstride = gridDim.x * 8;
        for (int row0 = blockIdx.x * 8 + wid; row0 < MT; row0 += 4 * rstride) {
            f32x4 v[4][4];
#pragma unroll
            for (int rr = 0; rr < 4; ++rr) { const int row = row0 + rr * rstride;
#pragma unroll
                for (int i = 0; i < 4; ++i) v[rr][i] = row < MT ? *(const f32x4*)(x + (size_t)row * DM + i * 256 + lane * 4) : (f32x4){0.f, 0.f, 0.f, 0.f}; }
#pragma unroll
            for (int rr = 0; rr < 4; ++rr) { const int row = row0 + rr * rstride; if (row >= MT) break;
                float ss = 0.f;
#pragma unroll
                for (int i = 0; i < 4; ++i) { const size_t o = (size_t)row * DM + i * 256 + lane * 4; const f32x4 q = v[rr][i];
                    u32x2 w; w.x = pack2(q[0], q[1]); w.y = pack2(q[2], q[3]); *(u32x2*)(xb + o) = w; ss += (q[0] * q[0] + q[1] * q[1]) + (q[2] * q[2] + q[3] * q[3]); }
#pragma unroll
                for (int off = 1; off < 64; off <<= 1) ss += __shfl_xor(ss, off);
                if (lane < 16) ssq[(size_t)lane * MT + row] = lane == 0 ? ss : 0.f;
            }
        }
    }
    bf16_t* T = (bf16_t*)lds;
    for (int t = blockIdx.x; t < 1296; t += gridDim.x) {
        int j = 0, tt = t; while (tt >= job_tiles(j)) { tt -= job_tiles(j); ++j; }
        const Job J = get_job(p, j); const int nkt = J.K >> 7; const int n0 = (tt / nkt) * 256, k0 = (tt % nkt) * 128;
        const int nq = tid & 63, kr = tid >> 6; bool w2; const int sc = map_col(J.kind, n0 + 4 * nq, w2); const float* Ws = w2 ? J.W2 : J.W;
        f32x4 v[16]; float gk[16];
#pragma unroll
        for (int i = 0; i < 16; ++i) { const int k = k0 + kr + 8 * i; v[i] = sc >= 0 ? *(const f32x4*)(Ws + (size_t)k * J.ldw + sc) : (f32x4){0.f, 0.f, 0.f, 0.f}; gk[i] = J.gain ? J.gain[k] : 1.0f; }
#pragma unroll
        for (int i = 0; i < 16; ++i) { const int kl = kr + 8 * i;
#pragma unroll
            for (int e = 0; e < 4; ++e) T[(4 * nq + e) * 130 + kl] = f2bf(v[i][e] * gk[i]); }
        __syncthreads();
        { const int n = tid >> 1, ks = tid & 1; const unsigned* src = (const unsigned*)(T + n * 130 + 64 * ks); bf16_t* d = J.dst + (size_t)(n0 + n) * J.K + k0 + 64 * ks;
#pragma unroll
          for (int q = 0; q < 8; ++q) { u32x4 w; w.x = src[4 * q]; w.y = src[4 * q + 1]; w.z = src[4 * q + 2]; w.w = src[4 * q + 3]; *(u32x4*)(d + 8 * q) = w; } }
        __syncthreads();
    }
}
#define MFMA32(a, b, c) __builtin_amdgcn_mfma_f32_32x32x16_bf16((a), (b), (c), 0, 0, 0)
#define MFMA16(a, b, c) __builtin_amdgcn_mfma_f32_16x16x32_bf16((a), (b), (c), 0, 0, 0)
constexpr int AT_GRP = 26880, AT_V = 9216, AT_S = 26624;
template <int MODE, int DV, bool CH = false>
DI void attn_item(KPtr p, unsigned char* ldsb, int b, int hp, int qblk) {
    constexpr int NDB = DV / 32;
    const int tid = otid(), lane = tid & 63, wid = tid >> 6, g = wid >> 2, w = wid & 3, r = lane & 31, h = lane >> 5, tg = tid & 255;
    constexpr bool SH = (MODE != 0);
    constexpr int NKC = SH ? 1 : 2, NVC = DV / 64, LSTR = SH ? 512 : 256;
    constexpr bool VFO = (MODE != 2);
    constexpr int BSTR = SH ? 2 * AT_GRP : 36864;
    const int tl = SH ? tid : tg;
    const int tok0 = b * SEQ, head = hp;
    const bf16_t *Qb, *Kb, *Vt; int ld; const float* ksc = nullptr;
    if (MODE == 0) { const bf16_t* P0 = (const bf16_t*)(p->ws + OFF_P0); Qb = P0 + hp * 128 + g * 64; Kb = P0 + 512 + hp * 128 + g * 64; ld = 1536; Vt = (const bf16_t*)(p->ws + OFF_VT0) + (size_t)(hp * 128) * MT; }
    else if (MODE == 1) { const bf16_t* P1 = (const bf16_t*)(p->ws + OFF_P1); Qb = P1 + 1024 + head * 64; Kb = P1 + 1536 + head * 64; ld = 2048; Vt = (const bf16_t*)(p->ws + OFF_VT1) + (size_t)(512 + head * 64) * MT; ksc = (const float*)(p->ws + OFF_FF) + (size_t)(b * 8 + head) * SEQ; }
    else { const bf16_t* QK = (const bf16_t*)p->out; Qb = QK + head * 64; Kb = QK + 256 + head * 64; ld = 512; Vt = (const bf16_t*)(p->ws + OFF_VT1) + (size_t)(head * 128) * MT; ksc = (const float*)(p->ws + OFF_MA) + (size_t)(b * 4 + head) * SEQ; }
    unsigned char* Kl = ldsb + (SH ? 0 : g * 9216); unsigned char* Vl = ldsb + (SH ? AT_V : 18432);
    const int qpos = SH ? 256 * qblk + 128 * g + 32 * w + r : 128 * qblk + 32 * w + r; const size_t tq = (size_t)tok0 + qpos;
    bf16x8 qf[4];
#pragma unroll
    for (int ks = 0; ks < 4; ++ks) qf[ks] = *(const bf16x8*)(Qb + tq * ld + 16 * ks + 8 * h);
    float Fref = 0.f, Mlq = 0.f, mtq = 0.f;
    if (MODE == 1) Fref = ksc[256 * qblk];
    if (MODE == 2) Mlq = ((const float*)(p->ws + OFF_MM))[(size_t)(b * 4 + head) * SEQ + qpos];
    f32x16 O[NDB];
#pragma unroll
    for (int d = 0; d < NDB; ++d)
#pragma unroll
        for (int i = 0; i < 16; ++i) O[d][i] = 0.f;
    float m_run = -1e30f, lsum = 0.f;
    const int nkt = SH ? 4 * (qblk + 1) : 2 * (qblk + 1), ktmax = SH ? 4 * qblk + 2 * g + (w >> 1) : 2 * qblk + (w >> 1), kdiag = SH ? 4 * qblk + 2 * g : 2 * qblk;
    u32x4 kreg[NKC], vreg[NVC]; float sreg = 0.f;
#define AT_LOAD(kt_) do { const size_t key0 = (size_t)tok0 + 64 * (kt_); \
        _Pragma("unroll") for (int i_ = 0; i_ < NKC; ++i_) { const int c_ = tl + LSTR * i_; kreg[i_] = *(const u32x4*)(Kb + (key0 + (c_ >> 3)) * ld + (c_ & 7) * 8); } \
        _Pragma("unroll") for (int i_ = 0; i_ < NVC; ++i_) { const int c_ = tid + 512 * i_; vreg[i_] = *(const u32x4*)(Vt + (size_t)(c_ >> 3) * MT + key0 + (c_ & 7) * 8); } \
        if (MODE != 0 && tl < 64) sreg = ksc[64 * (kt_) + tl]; } while (0)
#define AT_STORE(buf_) do { unsigned char* Kd_ = Kl + (buf_) * BSTR; unsigned char* Vd_ = Vl + (buf_) * BSTR; \
        _Pragma("unroll") for (int i_ = 0; i_ < NKC; ++i_) { const int c_ = tl + LSTR * i_; *(u32x4*)(Kd_ + (c_ >> 3) * 144 + (c_ & 7) * 16) = kreg[i_]; } \
        _Pragma("unroll") for (int i_ = 0; i_ < NVC; ++i_) { const int c_ = tid + 512 * i_; unsigned char* d_ = VFO ? Vd_ + (c_ >> 3) * 144 + ((c_ & 7) >> 1) * 32 + (c_ & 1) * 8 : Vd_ + (c_ >> 3) * 136 + (c_ & 7) * 16; u32x2 lo_, hi_; lo_.x = vreg[i_].x; lo_.y = vreg[i_].y; hi_.x = vreg[i_].z; hi_.y = vreg[i_].w; *(u32x2*)d_ = lo_; *(u32x2*)(d_ + (VFO ? 16 : 8)) = hi_; } \
        if (MODE != 0 && tl < 64) ((float*)(Kd_ + AT_S))[tl] = (MODE == 1) ? (Fref - sreg) * 8.0f : sreg; } while (0)
    const int kt0 = CH ? 4 * qblk : 0;
    AT_LOAD(kt0);
    AT_STORE(0);
    if (kt0 + 1 < nkt) AT_LOAD(kt0 + 1);
    __syncthreads();
    for (int kt = kt0; kt < nkt; ++kt) {
        const int cur = (kt - kt0) & 1;
        if (kt + 1 < nkt) AT_STORE(cur ^ 1);
        if (kt + 2 < nkt) AT_LOAD(kt + 2);
        unsigned char* const Kc = Kl + cur * BSTR; unsigned char* const Vc = Vl + cur * BSTR; float* const Sc = (float*)(Kc + AT_S);
        if (CH ? (kt == ktmax) : (kt <= ktmax)) {
            const bool diag = kt >= kdiag;
            bf16x8 kf[2][4]; f32x4 sv[2][4];
#pragma unroll
            for (int kb = 0; kb < 2; ++kb)
#pragma unroll
                for (int ks = 0; ks < 4; ++ks) kf[kb][ks] = *(const bf16x8*)(Kc + (32 * kb + r) * 144 + 32 * ks + 16 * h);
            if (MODE != 0) {
#pragma unroll
                for (int kb = 0; kb < 2; ++kb)
#pragma unroll
                    for (int gq = 0; gq < 4; ++gq) sv[kb][gq] = *(const f32x4*)(Sc + 32 * kb + 8 * gq + 4 * h);
            }
            __builtin_amdgcn_sched_barrier(0);
            f32x16 sacc[2];
#pragma unroll
            for (int kb = 0; kb < 2; ++kb) {
                if (MODE == 1) {
#pragma unroll
                    for (int gq = 0; gq < 4; ++gq) { sacc[kb][4 * gq] = sv[kb][gq][0]; sacc[kb][4 * gq + 1] = sv[kb][gq][1]; sacc[kb][4 * gq + 2] = sv[kb][gq][2]; sacc[kb][4 * gq + 3] = sv[kb][gq][3]; }
                } else {
#pragma unroll
                    for (int i = 0; i < 16; ++i) sacc[kb][i] = 0.f;
                }
            }
#pragma unroll
            for (int ks = 0; ks < 4; ++ks)
#pragma unroll
                for (int kb = 0; kb < 2; ++kb) sacc[kb] = MFMA32(kf[kb][ks], qf[ks], sacc[kb]);
            u32x4 vf0[2][2][2];
#pragma unroll
            for (int d = 0; d < 2; ++d)
#pragma unroll
                for (int kb = 0; kb < 2; ++kb)
#pragma unroll
                    for (int s2 = 0; s2 < 2; ++s2) {
                        if (VFO) vf0[d][kb][s2] = *(const u32x4*)(Vc + (32 * d + r) * 144 + (32 * kb + 16 * s2) * 2 + 16 * h);
                        else { const unsigned char* va = Vc + (32 * d + r) * 136 + (32 * kb + 16 * s2 + 4 * h) * 2;
                        const u32x2 lo = *(const u32x2*)va, hi = *(const u32x2*)(va + 16); vf0[d][kb][s2].x = lo.x; vf0[d][kb][s2].y = lo.y; vf0[d][kb][s2].z = hi.x; vf0[d][kb][s2].w = hi.y; }
                    }
            __builtin_amdgcn_sched_barrier(0);
            if (MODE != 2) {
                const float c = 0.125f * LOG2E;
                if (diag) {
#pragma unroll
                    for (int kb = 0; kb < 2; ++kb)
#pragma unroll
                        for (int i = 0; i < 16; ++i) { const int key = 64 * kt + 32 * kb + (i & 3) + 8 * (i >> 2) + 4 * h; if (key > qpos) sacc[kb][i] = -1e30f; }
                }
                float mx = -1e30f;
#pragma unroll
                for (int kb = 0; kb < 2; ++kb)
#pragma unroll
                    for (int i = 0; i < 16; ++i) mx = fmaxf(mx, sacc[kb][i]);
                mx = fmaxf(mx, __shfl_xor(mx, 32));
                const float m_new = fmaxf(m_run, mx), alpha = fast_exp2((m_run - m_new) * c), mc = m_new * c;
                m_run = m_new; lsum *= alpha;
                if (__builtin_amdgcn_ballot_w64(alpha != 1.0f) != 0ull) {
#pragma unroll
                    for (int d = 0; d < NDB; ++d)
#pragma unroll
                        for (int i = 0; i < 16; ++i) O[d][i] *= alpha;
                }
#pragma unroll
                for (int kb = 0; kb < 2; ++kb)
#pragma unroll
                    for (int i = 0; i < 16; ++i) { const float pv = fast_exp2(sacc[kb][i] * c - mc); lsum += pv; sacc[kb][i] = pv; }
            } else {
#pragma unroll
                for (int kb = 0; kb < 2; ++kb)
#pragma unroll
                    for (int gq = 0; gq < 4; ++gq) {
#pragma unroll
                        for (int e = 0; e < 4; ++e) {
                            const int i = 4 * gq + e; float val = sacc[kb][i] * fast_exp2(sv[kb][gq][e] - Mlq);
                            if (diag) { const int key = 64 * kt + 32 * kb + 8 * gq + 4 * h + e; if (key > qpos) val = 0.f; }
                            lsum += val; sacc[kb][i] = val;
                        }
                    }
            }
            bf16x8 P[2][2];
#pragma unroll
            for (int kb = 0; kb < 2; ++kb)
#pragma unroll
                for (int s2 = 0; s2 < 2; ++s2) { u32x4 pk; pk.x = pack2(sacc[kb][8 * s2], sacc[kb][8 * s2 + 1]); pk.y = pack2(sacc[kb][8 * s2 + 2], sacc[kb][8 * s2 + 3]); pk.z = pack2(sacc[kb][8 * s2 + 4], sacc[kb][8 * s2 + 5]); pk.w = pack2(sacc[kb][8 * s2 + 6], sacc[kb][8 * s2 + 7]); P[kb][s2] = __builtin_bit_cast(bf16x8, pk); }
            u32x4 vf1[2][2][2];
            if (NDB == 4) {
#pragma unroll
                for (int d = 0; d < 2; ++d)
#pragma unroll
                    for (int kb = 0; kb < 2; ++kb)
#pragma unroll
                        for (int s2 = 0; s2 < 2; ++s2) {
                            if (VFO) vf1[d][kb][s2] = *(const u32x4*)(Vc + (32 * (d + 2) + r) * 144 + (32 * kb + 16 * s2) * 2 + 16 * h);
                            else { const unsigned char* va = Vc + (32 * (d + 2) + r) * 136 + (32 * kb + 16 * s2 + 4 * h) * 2;
                            const u32x2 lo = *(const u32x2*)va, hi = *(const u32x2*)(va + 16); vf1[d][kb][s2].x = lo.x; vf1[d][kb][s2].y = lo.y; vf1[d][kb][s2].z = hi.x; vf1[d][kb][s2].w = hi.y; }
                        }
            }
            __builtin_amdgcn_sched_barrier(0);
#pragma unroll
            for (int kb = 0; kb < 2; ++kb)
#pragma unroll
                for (int s2 = 0; s2 < 2; ++s2)
#pragma unroll
                    for (int d = 0; d < 2; ++d) O[d] = MFMA32(__builtin_bit_cast(bf16x8, vf0[d][kb][s2]), P[kb][s2], O[d]);
            if (NDB == 4) {
#pragma unroll
                for (int kb = 0; kb < 2; ++kb)
#pragma unroll
                    for (int s2 = 0; s2 < 2; ++s2)
#pragma unroll
                        for (int d = 0; d < 2; ++d) O[d + 2] = MFMA32(__builtin_bit_cast(bf16x8, vf1[d][kb][s2]), P[kb][s2], O[d + 2]);
            }
        }
        __syncthreads();
    }
#undef AT_STORE
#undef AT_LOAD
    if (CH && MODE == 2 && ktmax > 0) {
        const int bh = b * 4 + head; const bf16_t* LCp = (const bf16_t*)p->out + (size_t)8 * 1024 * 1024 + ((size_t)(bh * 64 + ktmax - 1) * 160) * 64;
        const float sc = fast_exp2(((const float*)(p->ws + OFF_MM))[(size_t)bh * SEQ + 64 * ktmax - 1] - Mlq);
#pragma unroll
        for (int db = 0; db < 5; ++db) {
            f32x16 I;
#pragma unroll
            for (int i = 0; i < 16; ++i) I[i] = 0.f;
#pragma unroll
            for (int ks = 0; ks < 4; ++ks) { const bf16x8 af = *(const bf16x8*)(LCp + (size_t)(32 * db + r) * 64 + 16 * ks + 8 * h); I = MFMA32(af, qf[ks], I); }
            if (db < 4) {
#pragma unroll
                for (int i = 0; i < 16; ++i) O[db < 4 ? db : 0][i] += I[i] * sc;
            } else if (h == 0) lsum += I[0] * sc;
        }
    }
    lsum += __shfl_xor(lsum, 32);
    if (MODE == 1) {
        const float inv = 1.0f / lsum; bf16_t* yc = (bf16_t*)(p->ws + OFF_YC1) + tq * 1024 + 512 + head * 64;
#pragma unroll
        for (int d = 0; d < NDB; ++d)
#pragma unroll
            for (int gq = 0; gq < 4; ++gq) { u32x2 wv; wv.x = pack2(O[d][4 * gq] * inv, O[d][4 * gq + 1] * inv); wv.y = pack2(O[d][4 * gq + 2] * inv, O[d][4 * gq + 3] * inv); *(u32x2*)(yc + 32 * d + 8 * gq + 4 * h) = wv; }
    } else if (MODE == 2) {
        mtq = ((const float*)(p->ws + OFF_MTT))[(size_t)(b * 4 + head) * SEQ + qpos];
        const float dd = fmaxf(fabsf(lsum), expf(-mtq)), inv = 1.0f / dd; float ss = 0.f;
#pragma unroll
        for (int d = 0; d < NDB; ++d)
#pragma unroll
            for (int i = 0; i < 16; ++i) { O[d][i] *= inv; ss += O[d][i] * O[d][i]; }
        ss += __shfl_xor(ss, 32);
        const float rstd = rsqrtf(ss * (1.0f / 128.0f) + NEPS);
        const bf16_t* og = (const bf16_t*)(p->ws + OFF_P1) + tq * 2048 + 512 + head * 128; const float* gn = p->in[37] + head * 128;
        bf16_t* yc = (bf16_t*)(p->ws + OFF_YC1) + tq * 1024 + head * 128;
#pragma unroll
        for (int d = 0; d < NDB; ++d)
#pragma unroll
            for (int gq = 0; gq < 4; ++gq) {
                const int dv = 32 * d + 8 * gq + 4 * h; const u32x2 ow = *(const u32x2*)(og + dv); const f32x4 gv = *(const f32x4*)(gn + dv);
                const float o0 = O[d][4 * gq] * rstd * gv[0] * sigmoidf_(bflo(ow.x)), o1 = O[d][4 * gq + 1] * rstd * gv[1] * sigmoidf_(bfhi(ow.x));
                const float o2 = O[d][4 * gq + 2] * rstd * gv[2] * sigmoidf_(bflo(ow.y)), o3 = O[d][4 * gq + 3] * rstd * gv[3] * sigmoidf_(bfhi(ow.y));
                u32x2 wv; wv.x = pack2(o0, o1); wv.y = pack2(o2, o3); *(u32x2*)(yc + dv) = wv;
            }
    } else {
        const float inv = 1.0f / lsum; float* X = (float*)ldsb;
        __syncthreads();
        if (g == 1) {
#pragma unroll
            for (int d = 0; d < NDB; ++d)
#pragma unroll
                for (int i = 0; i < 16; ++i) X[(32 * d + (i & 3) + 8 * (i >> 2) + 4 * h) * 128 + 32 * w + r] = O[d][i] * inv;
        }
        __syncthreads();
        if (g == 0) {
            const float lam = ((const float*)(p->ws + OFF_SCAL))[0]; float ss = 0.f;
#pragma unroll
            for (int d = 0; d < NDB; ++d)
#pragma unroll
                for (int i = 0; i < 16; ++i) { const float v = O[d][i] * inv - lam * X[(32 * d + (i & 3) + 8 * (i >> 2) + 4 * h) * 128 + 32 * w + r]; O[d][i] = v; ss += v * v; }
            ss += __shfl_xor(ss, 32);
            const float rstd = rsqrtf(ss * (1.0f / 128.0f) + NEPS) * 0.8f; const float* gn = p->in[11];
            bf16_t* yc = (bf16_t*)(p->ws + OFF_YC0) + tq * 1024 + hp * 128;
#pragma unroll
            for (int d = 0; d < NDB; ++d)
#pragma unroll
                for (int gq = 0; gq < 4; ++gq) {
                    const int dv = 32 * d + 8 * gq + 4 * h; const f32x4 gv = *(const f32x4*)(gn + dv);
                    u32x2 wv; wv.x = pack2(O[d][4 * gq] * rstd * gv[0], O[d][4 * gq + 1] * rstd * gv[1]); wv.y = pack2(O[d][4 * gq + 2] * rstd * gv[2], O[d][4 * gq + 3] * rstd * gv[3]); *(u32x2*)(yc + dv) = wv;
                }
        }
    }
}

DI void mlstm_local(KPtr p, unsigned char* lds, int item_) {
    const int tid_ = otid(); const int lane = tid_ & 63, wid = __builtin_amdgcn_readfirstlane(tid_ >> 6); const int item = __builtin_amdgcn_readfirstlane(item_);
    const int bh = item >> 3, c = (item & 7) * 8 + wid, b = bh >> 2, head = bh & 3, r = lane & 31, h = lane >> 5;
    const size_t tok0 = (size_t)b * SEQ + c * 64;
    const float* mA = (const float*)(p->ws + OFF_MA) + (size_t)bh * SEQ + c * 64; const float mend = ((const float*)(p->ws + OFF_MM))[(size_t)bh * SEQ + c * 64 + 63];
    const bf16_t* Kg = (const bf16_t*)p->out + tok0 * 512 + 256 + head * 64;
    unsigned char* Kl = lds + wid * 9216;
    __syncthreads();
#pragma unroll
    for (int i = 0; i < 8; ++i) {
        const int cc = lane + 64 * i, row = cc >> 3, part = cc & 7; const u32x4 kv = *(const u32x4*)(Kg + (size_t)row * 512 + part * 8); const float wgt = fast_exp2(mA[row] - mend);
        u32x4 o; o.x = pack2(bflo(kv.x) * wgt, bfhi(kv.x) * wgt); o.y = pack2(bflo(kv.y) * wgt, bfhi(kv.y) * wgt); o.z = pack2(bflo(kv.z) * wgt, bfhi(kv.z) * wgt); o.w = pack2(bflo(kv.w) * wgt, bfhi(kv.w) * wgt);
        *(u32x4*)(Kl + row * 144 + part * 16) = o;
    }
    asm volatile("s_waitcnt lgkmcnt(0)" ::: "memory");
    bf16x8 bfr[2][4];
#pragma unroll
    for (int nb = 0; nb < 2; ++nb)
#pragma unroll
        for (int ks = 0; ks < 4; ++ks)
#pragma unroll
            for (int j = 0; j < 8; ++j) bfr[nb][ks][j] = (short)*(const bf16_t*)(Kl + (16 * ks + 8 * h + j) * 144 + (32 * nb + r) * 2);
    const bf16_t* Vt = (const bf16_t*)(p->ws + OFF_VT1) + (size_t)(head * 128) * MT + tok0;
    bf16_t* LC = (bf16_t*)p->out + (size_t)8 * 1024 * 1024 + ((size_t)(bh * 64 + c) * 160) * 64;
#pragma unroll 1
    for (int db = 0; db < 5; ++db) {
        bf16x8 af[4];
        if (db < 4) {
#pragma unroll
            for (int ks = 0; ks < 4; ++ks) af[ks] = *(const bf16x8*)(Vt + (size_t)(32 * db + r) * MT + 16 * ks + 8 * h);
        } else {
            const short one = (r == 0) ? (short)0x3F80 : (short)0;
#pragma unroll
            for (int ks = 0; ks < 4; ++ks)
#pragma unroll
                for (int j = 0; j < 8; ++j) af[ks][j] = one;
        }
#pragma unroll
        for (int nb = 0; nb < 2; ++nb) {
            f32x16 acc;
#pragma unroll
            for (int i = 0; i < 16; ++i) acc[i] = 0.f;
#pragma unroll
            for (int ks = 0; ks < 4; ++ks) acc = MFMA32(af[ks], bfr[nb][ks], acc);
#pragma unroll
            for (int i = 0; i < 16; ++i) LC[(size_t)(32 * db + (i & 3) + 8 * (i >> 2) + 4 * h) * 64 + 32 * nb + r] = f2bf(acc[i]);
        }
    }
}
DI void mlstm_prefix(KPtr p) {
    const int tid = otid(); const float* mM = (const float*)(p->ws + OFF_MM);
    for (int idx = blockIdx.x * 512 + tid; idx < 16 * 5120; idx += gridDim.x * 512) {
        const int bh = idx / 5120, e = idx % 5120;
        unsigned* base = (unsigned*)((bf16_t*)p->out + (size_t)8 * 1024 * 1024) + (size_t)bh * 64 * 5120 + e;
        const float* mMb = mM + (size_t)bh * SEQ; float c0 = 0.f, c1 = 0.f;
#pragma unroll 1
        for (int hb = 0; hb < 4; ++hb) {
            unsigned wv[16]; float gd[16];
#pragma unroll
            for (int i = 0; i < 16; ++i) { const int c = hb * 16 + i; wv[i] = base[(size_t)c * 5120]; gd[i] = c == 0 ? 0.f : fast_exp2(mMb[64 * c - 1] - mMb[64 * c + 63]); }
#pragma unroll
            for (int i = 0; i < 16; ++i) { c0 = gd[i] * c0 + bflo(wv[i]); c1 = gd[i] * c1 + bfhi(wv[i]); wv[i] = pack2(c0, c1); }
#pragma unroll
            for (int i = 0; i < 16; ++i) base[(size_t)(hb * 16 + i) * 5120] = wv[i];
        }
    }
}

DI void s5_consts(KPtr p, int g, int lane, float& ar, float& ai, unsigned (&bbr)[8], unsigned (&bbi)[8]) {
    const float lr = p->in[12][g * 64 + lane], li = p->in[13][g * 64 + lane], dt = expf(p->in[14][g]);
    const float mag = expf(lr * dt); ar = mag * cosf(li * dt); ai = mag * sinf(li * dt);
    const float den = lr * lr + li * li, gr = ((ar - 1.0f) * lr + ai * li) / den, gi = (ai * lr - (ar - 1.0f) * li) / den;
    const f32x4* br4 = (const f32x4*)(p->in[15] + (size_t)(g * 64 + lane) * 16); const f32x4* bi4 = (const f32x4*)(p->in[16] + (size_t)(g * 64 + lane) * 16);
#pragma unroll
    for (int q = 0; q < 4; ++q) { const f32x4 br = br4[q], bi = bi4[q];
        bbr[2 * q] = pack2(gr * br[0] - gi * bi[0], gr * br[1] - gi * bi[1]); bbr[2 * q + 1] = pack2(gr * br[2] - gi * bi[2], gr * br[3] - gi * bi[3]);
        bbi[2 * q] = pack2(gr * bi[0] + gi * br[0], gr * bi[1] + gi * br[1]); bbi[2 * q + 1] = pack2(gr * bi[2] + gi * br[2], gr * bi[3] + gi * br[3]); }
}
constexpr int S5_X = 34816, S5_XW = 8448, S5_BT = 102400;
DI void s5_setup(KPtr p, unsigned char* lds, int g, int lane, float& ar, float& ai, bf16x8 (&bfr)[8]) {
    unsigned bbr[8], bbi[8]; s5_consts(p, g, lane, ar, ai, bbr, bbi);
    __syncthreads();
    u32x4* bt = (u32x4*)(lds + S5_BT); u32x4 w;
    w.x = bbr[0]; w.y = bbr[1]; w.z = bbr[2]; w.w = bbr[3]; bt[lane * 2] = w; w.x = bbr[4]; w.y = bbr[5]; w.z = bbr[6]; w.w = bbr[7]; bt[lane * 2 + 1] = w;
    w.x = bbi[0]; w.y = bbi[1]; w.z = bbi[2]; w.w = bbi[3]; bt[(64 + lane) * 2] = w; w.x = bbi[4]; w.y = bbi[5]; w.z = bbi[6]; w.w = bbi[7]; bt[(64 + lane) * 2 + 1] = w;
    __syncthreads();
    const int col = lane & 15, quad = lane >> 4;
#pragma unroll
    for (int nb = 0; nb < 8; ++nb) bfr[nb] = *(const bf16x8*)(lds + S5_BT + ((16 * nb + col) * 16 + 8 * (quad & 1)) * 2);
}
#define S5_XBLOCK(a_) do { const f32x4 z4_ = {0.f, 0.f, 0.f, 0.f}; \
        _Pragma("unroll") for (int nb_ = 0; nb_ < 8; ++nb_) { const f32x4 d_ = MFMA16((a_), bfr[nb_], z4_); \
            _Pragma("unroll") for (int j_ = 0; j_ < 4; ++j_) Xw[(4 * quad + j_) * 132 + 16 * nb_ + col] = d_[j_]; } \
        asm volatile("s_waitcnt lgkmcnt(0)" ::: "memory"); } while (0)
DI void s5_pass1(KPtr p, unsigned char* lds, int item_) {
    const int tid_ = otid(); const int lane = tid_ & 63, wid = __builtin_amdgcn_readfirstlane(tid_ >> 6); const int item = __builtin_amdgcn_readfirstlane(item_);
    const int bg = item >> 2, b = bg >> 5, g = bg & 31, c = (item & 3) * 8 + wid, col = lane & 15, quad = lane >> 4;
    float ar, ai; bf16x8 bfr[8]; s5_setup(p, lds, g, lane, ar, ai, bfr);
    float* Xw = (float*)(lds + S5_X + wid * S5_XW);
    const bf16_t* ub = (const bf16_t*)(p->ws + OFF_P0) + (size_t)(b * SEQ + c * 128 + col) * 1536 + 1024 + g * 16 + 8 * (quad & 1);
    const bf16x8 zero8 = {0, 0, 0, 0, 0, 0, 0, 0};
    float hr = 0.f, hi = 0.f;
    bf16x8 an = quad < 2 ? *(const bf16x8*)ub : zero8;
#pragma unroll 1
    for (int blk = 0; blk < 8; ++blk) {
        const bf16x8 a = an; if (blk < 7) an = quad < 2 ? *(const bf16x8*)(ub + (size_t)16 * (blk + 1) * 1536) : zero8;
        S5_XBLOCK(a);
#pragma unroll
        for (int tt = 0; tt < 16; ++tt) { const float xr = Xw[tt * 132 + lane], xi = Xw[tt * 132 + 64 + lane]; const float nr = ar * hr - ai * hi + xr, ni = ar * hi + ai * hr + xi; hr = nr; hi = ni; }
        asm volatile("s_waitcnt lgkmcnt(0)" ::: "memory");
    }
    f32x2 e; e.x = hr; e.y = hi; ((f32x2*)(p->ws + OFF_S5E))[((size_t)bg * 32 + c) * 64 + lane] = e;
}
DI void s5_pass3(KPtr p, unsigned char* lds, int item_) {
    const int tid_ = otid(); const int lane = tid_ & 63, wid = __builtin_amdgcn_readfirstlane(tid_ >> 6); const int item = __builtin_amdgcn_readfirstlane(item_);
    const int bg = item >> 2, b = bg >> 5, g = bg & 31, c = (item & 3) * 8 + wid, col = lane & 15, quad = lane >> 4;
    float ar, ai; bf16x8 bfr[8]; s5_setup(p, lds, g, lane, ar, ai, bfr);
    float pr = ar, pi = ai;
#pragma unroll
    for (int i = 0; i < 7; ++i) { const float t = pr * pr - pi * pi; pi = 2.0f * pr * pi; pr = t; }
    float hr = 0.f, hi = 0.f; const f32x2* E = (const f32x2*)(p->ws + OFF_S5E) + (size_t)bg * 32 * 64 + lane;
#pragma unroll 8
    for (int cc = 0; cc < 32; ++cc) {
        const bool on = cc < c; f32x2 e = {0.f, 0.f}; if (on) e = E[cc * 64];
        const float qr = on ? pr : 1.0f, qi = on ? pi : 0.0f;
        const float nr = qr * hr - qi * hi + e.x, ni = qr * hi + qi * hr + e.y; hr = nr; hi = ni;
    }
    const int hh = col;
    bf16x8 cb[4];
#pragma unroll
    for (int ks = 0; ks < 4; ++ks)
#pragma unroll
        for (int j = 0; j < 8; ++j) { const int k = 32 * ks + 8 * quad + j, sp = k >> 1; const float v = (k & 1) ? -p->in[18][(size_t)(g * 16 + hh) * 64 + sp] : p->in[17][(size_t)(g * 16 + hh) * 64 + sp]; cb[ks][j] = (short)f2bf(v); }
    const float dsk = p->in[19][g * 16 + hh];
    const bf16_t* P0 = (const bf16_t*)(p->ws + OFF_P0); bf16_t* Z = (bf16_t*)(p->ws + OFF_Z); const int tokb = b * SEQ + c * 128;
    bf16_t* Hs = (bf16_t*)(lds + wid * 4352);
    float* Xw = (float*)(lds + S5_X + wid * S5_XW);
    const bf16_t* ub = P0 + (size_t)(tokb + col) * 1536 + 1024 + g * 16 + 8 * (quad & 1);
    const bf16x8 zero8 = {0, 0, 0, 0, 0, 0, 0, 0};
    bf16x8 an = quad < 2 ? *(const bf16x8*)ub : zero8;
#pragma unroll 1
    for (int blk = 0; blk < 8; ++blk) {
        const bf16x8 a = an; if (blk < 7) an = quad < 2 ? *(const bf16x8*)(ub + (size_t)16 * (blk + 1) * 1536) : zero8;
        bf16_t uu4[4];
#pragma unroll
        for (int j = 0; j < 4; ++j) uu4[j] = P0[((size_t)tokb + blk * 16 + 4 * quad + j) * 1536 + 1024 + g * 16 + hh];
        S5_XBLOCK(a);
#pragma unroll
        for (int tt = 0; tt < 16; ++tt) {
            const float xr = Xw[tt * 132 + lane], xi = Xw[tt * 132 + 64 + lane]; const float nr = ar * hr - ai * hi + xr, ni = ar * hi + ai * hr + xi; hr = nr; hi = ni;
            *(unsigned*)(Hs + tt * 136 + 2 * lane) = pack2(hr, hi);
        }
        asm volatile("s_waitcnt lgkmcnt(0)" ::: "memory");
        f32x4 acc = {0.f, 0.f, 0.f, 0.f};
#pragma unroll
        for (int ks = 0; ks < 4; ++ks) { const bf16x8 af = *(const bf16x8*)(Hs + hh * 136 + 32 * ks + 8 * quad); acc = MFMA16(af, cb[ks], acc); }
        asm volatile("s_waitcnt lgkmcnt(0)" ::: "memory");
#pragma unroll
        for (int j = 0; j < 4; ++j) {
            const size_t tok = (size_t)tokb + blk * 16 + 4 * quad + j; const float uu = bf2f(uu4[j]);
            const float y = acc[j] + dsk * uu; const float zz = y * sigmoidf_(1.5957691216057308f * (y + 0.044715f * y * y * y));
            Z[tok * 512 + g * 16 + hh] = f2bf(zz);
        }
    }
}
#undef S5_XBLOCK

DI void gates_job(KPtr p) {
    const int tid = otid(), lane = tid & 63, wid = __builtin_amdgcn_readfirstlane(tid >> 6), r16 = lane & 15, quad = lane >> 4;
    const bf16_t* xb = (const bf16_t*)(p->ws + OFF_XB); const bf16_t* Wg = (const bf16_t*)(p->ws + OFF_WIN1) + (size_t)2048 * 1024;
    const float* ssq = (const float*)(p->ws + OFF_SSQ); float* gates = (float*)(p->ws + OFF_GATES);
    for (int tb = blockIdx.x * 8 + wid; tb < MT / 16; tb += gridDim.x * 8) {
        const int t0 = tb * 16;
        const bf16_t* ap = xb + (size_t)(t0 + r16) * 1024 + 8 * quad; const bf16_t* bp = Wg + (size_t)r16 * 1024 + 8 * quad;
        f32x4 acc = {0.f, 0.f, 0.f, 0.f};
#pragma unroll 1
        for (int k8 = 0; k8 < 4; ++k8) {
            bf16x8 a[8], b[8];
#pragma unroll
            for (int i = 0; i < 8; ++i) { a[i] = *(const bf16x8*)(ap + 32 * (8 * k8 + i)); b[i] = *(const bf16x8*)(bp + 32 * (8 * k8 + i)); }
#pragma unroll
            for (int i = 0; i < 8; ++i) acc = MFMA16(a[i], b[i], acc);
        }
        f32x4 sq = *(const f32x4*)(ssq + (size_t)r16 * MT + t0 + 4 * quad);
#pragma unroll
        for (int off = 1; off < 16; off <<= 1) { sq[0] += __shfl_xor(sq[0], off); sq[1] += __shfl_xor(sq[1], off); sq[2] += __shfl_xor(sq[2], off); sq[3] += __shfl_xor(sq[3], off); }
        { f32x4 gv;
#pragma unroll
          for (int j = 0; j < 4; ++j) gv[j] = acc[j] * rsqrtf(sq[j] * (1.0f / 1024.0f) + NEPS); *(f32x4*)(gates + (size_t)r16 * MT + t0 + 4 * quad) = gv; }
    }
}

DI float logsig(float x) { return fminf(x, 0.f) - log1pf(expf(-fabsf(x))); }
DI void phase_l1prep(KPtr p, unsigned char* lds) {
    const int tid = otid(), lane = tid & 63, wid = tid >> 6;
    const bf16_t* P1 = (const bf16_t*)(p->ws + OFF_P1); bf16_t* QK = (bf16_t*)p->out; const float* G = (const float*)(p->ws + OFF_GATES);
    const int nscan = gridDim.x > 96 ? 48 : 0;
    if ((int)blockIdx.x < 48) {
        const int task = blockIdx.x; const bool ml = task < 16; const int t2 = ml ? task : task - 16; const int b = ml ? (t2 >> 2) : (t2 >> 3), hh = ml ? (t2 & 3) : (t2 & 7);
        const float bfv = ml ? p->in[36][hh] : p->in[38][hh], biv = ml ? p->in[35][hh] : 0.f; const int fcol = ml ? 4 + hh : 8 + hh, icol = hh;
        float* fF = (float*)(p->ws + OFF_FF) + (size_t)t2 * SEQ; float* mA = (float*)(p->ws + OFF_MA) + (size_t)t2 * SEQ; float* mM = (float*)(p->ws + OFF_MM) + (size_t)t2 * SEQ; float* mT = (float*)(p->ws + OFF_MTT) + (size_t)t2 * SEQ;
        double* shd = (double*)lds; float* shm = (float*)(lds + 64);
        const int pos0 = wid * 512 + lane; const float* Gf = G + (size_t)fcol * MT + (size_t)b * SEQ + pos0; const float* Gi = G + (size_t)icol * MT + (size_t)b * SEQ + pos0;
        float v[8], ig[8];
#pragma unroll
        for (int ch = 0; ch < 8; ++ch) { v[ch] = logsig(Gf[ch * 64] + bfv); ig[ch] = ml ? Gi[ch * 64] + biv : 0.f; }
#pragma unroll
        for (int off = 1; off < 64; off <<= 1) {
#pragma unroll
            for (int ch = 0; ch < 8; ++ch) { const float t = __shfl_up(v[ch], off); if (lane >= off) v[ch] += t; }
        }
        double Fl[8]; double Fc = 0.0;
#pragma unroll
        for (int ch = 0; ch < 8; ++ch) { const float tot = __shfl(v[ch], 63); Fl[ch] = Fc + (double)v[ch]; Fc += (double)tot; }
        __syncthreads();
        if (lane == 0) shd[wid] = Fc;
        __syncthreads();
        double base = 0.0;
        for (int w2 = 0; w2 < wid; ++w2) base += shd[w2];
        float Fv[8];
#pragma unroll
        for (int ch = 0; ch < 8; ++ch) Fv[ch] = (float)(base + Fl[ch]);
        if (!ml) {
#pragma unroll
            for (int ch = 0; ch < 8; ++ch) fF[pos0 + ch * 64] = Fv[ch];
        } else {
            float a[8], cm[8];
#pragma unroll
            for (int ch = 0; ch < 8; ++ch) { a[ch] = ig[ch] - Fv[ch]; cm[ch] = a[ch]; mA[pos0 + ch * 64] = a[ch] * LOG2E; }
#pragma unroll
            for (int off = 1; off < 64; off <<= 1) {
#pragma unroll
                for (int ch = 0; ch < 8; ++ch) { const float t = __shfl_up(cm[ch], off); if (lane >= off) cm[ch] = fmaxf(cm[ch], t); }
            }
            float Mc = -3.0e38f; float Ml[8];
#pragma unroll
            for (int ch = 0; ch < 8; ++ch) { const float tot = __shfl(cm[ch], 63); Ml[ch] = fmaxf(Mc, cm[ch]); Mc = fmaxf(Mc, tot); }
            if (lane == 0) shm[wid] = Mc;
            __syncthreads();
            float bm = 0.f;
            for (int w2 = 0; w2 < wid; ++w2) bm = fmaxf(bm, shm[w2]);
#pragma unroll
            for (int ch = 0; ch < 8; ++ch) { const float Mr = fmaxf(bm, Ml[ch]); mM[pos0 + ch * 64] = Mr * LOG2E; mT[pos0 + ch * 64] = Fv[ch] + Mr; }
        }
    }
    const float* cw = p->in[33]; const float* cbv = p->in[34];
    if ((int)blockIdx.x >= nscan)
    for (int idx = ((int)blockIdx.x - nscan) * 512 + tid; idx < MT * 64; idx += ((int)gridDim.x - nscan) * 512) {
        const int tok = idx >> 6, c8 = (idx & 63) * 8, pos = tok & (SEQ - 1);
        float acc[8];
#pragma unroll
        for (int e = 0; e < 8; ++e) acc[e] = cbv[c8 + e];
#pragma unroll
        for (int j = 0; j < 4; ++j) {
            if (pos - 3 + j >= 0) {
                const u32x4 xv = *(const u32x4*)(P1 + (size_t)(tok - 3 + j) * 2048 + c8); const f32x4 w0 = *(const f32x4*)(cw + j * 512 + c8), w1 = *(const f32x4*)(cw + j * 512 + c8 + 4);
                acc[0] += w0[0] * bflo(xv.x); acc[1] += w0[1] * bfhi(xv.x); acc[2] += w0[2] * bflo(xv.y); acc[3] += w0[3] * bfhi(xv.y);
                acc[4] += w1[0] * bflo(xv.z); acc[5] += w1[1] * bfhi(xv.z); acc[6] += w1[2] * bflo(xv.w); acc[7] += w1[3] * bfhi(xv.w);
            }
        }
        const float sc = c8 < 256 ? 0.125f : 1.0f;
#pragma unroll
        for (int e = 0; e < 8; ++e) acc[e] = acc[e] * sigmoidf_(acc[e]) * sc;
        u32x4 o; o.x = pack2(acc[0], acc[1]); o.y = pack2(acc[2], acc[3]); o.z = pack2(acc[4], acc[5]); o.w = pack2(acc[6], acc[7]);
        *(u32x4*)(QK + (size_t)tok * 512 + c8) = o;
    }
}

DI void phase_final(KPtr p) {
    const int tid_ = otid(); const int lane = tid_ & 63, wid = tid_ >> 6; const float* ssq = (const float*)(p->ws + OFF_SSQ); const float* gn = p->in[44]; float* out = p->out; const bf16_t* xbf = (const bf16_t*)(p->ws + OFF_XB);
    for (int row = blockIdx.x * 8 + wid; row < MT; row += gridDim.x * 8) {
        float s = lane < 16 ? ssq[(size_t)lane * MT + row] : 0.f;
#pragma unroll
        for (int off = 1; off < 16; off <<= 1) s += __shfl_xor(s, off);
        s = __shfl(s, 0);
        const float rstd = rsqrtf(s * (1.0f / 1024.0f) + NEPS);
#pragma unroll
        for (int i = 0; i < 4; ++i) { const size_t o = (size_t)row * DM + i * 256 + lane * 4; const u32x2 w0 = *(const u32x2*)(xbf + o); f32x4 v; v[0] = bflo(w0.x); v[1] = bfhi(w0.x); v[2] = bflo(w0.y); v[3] = bfhi(w0.y); const f32x4 gv = *(const f32x4*)(gn + i * 256 + lane * 4); *(f32x4*)(out + o) = v * gv * rstd; }
    }
}

#define XB_TMO      128
#define XB_XCNT(j)  (256  + 64 * (j))
#define XB_XSUB(j)  (1280 + 64 * (j))
#define XB_XGEN(j)  (2304 + 64 * (j))
#define XB_TOP      3328
#define XB_TOPGEN   3392
#define XB_SPIN_CAP (1u << 22)
DI unsigned xb_ld(unsigned* q) { return __hip_atomic_load(q, __ATOMIC_RELAXED, __HIP_MEMORY_SCOPE_AGENT); }
DI unsigned xb_add(unsigned* q, unsigned v) { return __hip_atomic_fetch_add(q, v, __ATOMIC_RELAXED, __HIP_MEMORY_SCOPE_AGENT); }
DI unsigned xb_xcc_id() { return (unsigned)__builtin_amdgcn_s_getreg((3 << 11) | 20) & 0xFu; }
#define XB_SPIN(cond, bar) do { unsigned _sp = 0; while (cond) { __builtin_amdgcn_s_sleep(1); \
    if ((++_sp & 255u) == 0u) { if (xb_ld(&(bar)[XB_TMO])) break; if (_sp > XB_SPIN_CAP) { atomicAdd(&(bar)[XB_TMO], 1u); break; } } } } while (0)
DI void xcd_barrier_complete(unsigned* bar, unsigned x, unsigned& nloc, unsigned& nx) {
    const unsigned G = gridDim.x; unsigned sum, cnt, mine, sp = 0u;
    for (;;) {
        sum = 0u; cnt = 0u; mine = 0u;
#pragma unroll
        for (unsigned j = 0; j < 16; ++j) { const unsigned c = xb_ld(&bar[XB_XCNT(j)]); sum += c; cnt += (c > 0u) ? 1u : 0u; mine = (j == x) ? c : mine; }
        if (sum == G) break;
        __builtin_amdgcn_s_sleep(1);
        if ((++sp & 255u) == 0u) { if (xb_ld(&bar[XB_TMO])) break; if (sp > XB_SPIN_CAP) { atomicAdd(&bar[XB_TMO], 1u); break; } }
    }
    nloc = mine > 0u ? mine : 1u; nx = cnt > 0u ? cnt : 1u;
}
DI void grid_barrier(unsigned* bar, volatile unsigned* st) {
    asm volatile("s_waitcnt vmcnt(0)" ::: "memory");
    __syncthreads();
    if (threadIdx.x == 0) {
        const unsigned x = xb_xcc_id();
        __builtin_amdgcn_s_waitcnt(0);
        unsigned nloc = st[0], nx = st[1];
        if (nloc == 0u) { xcd_barrier_complete(bar, x, nloc, nx); st[0] = nloc; st[1] = nx; }
        const unsigned old = xb_add(&bar[XB_XSUB(x)], 1u);
        const unsigned gen = old / nloc;
        if (old + 1u == (gen + 1u) * nloc) {
            __builtin_amdgcn_fence(__ATOMIC_RELEASE, "agent");
            asm volatile("s_waitcnt vmcnt(0)" ::: "memory");
            const unsigned og = xb_add(&bar[XB_TOP], 1u);
            const unsigned tg = og / nx;
            if (og + 1u == (tg + 1u) * nx) xb_add(&bar[XB_TOPGEN], 1u);
            else XB_SPIN(xb_ld(&bar[XB_TOPGEN]) == tg, bar);
            __builtin_amdgcn_fence(__ATOMIC_ACQUIRE, "agent");
            xb_add(&bar[XB_XGEN(x)], 1u);
            asm volatile("s_waitcnt vmcnt(0)" ::: "memory");
        } else {
            XB_SPIN(xb_ld(&bar[XB_XGEN(x)]) == gen, bar);
            __builtin_amdgcn_fence(__ATOMIC_ACQUIRE, "agent");
            asm volatile("s_waitcnt vmcnt(0)" ::: "memory");
        }
    }
    __syncthreads();
}

#ifdef NO_S5
#define S5P1(...)
#define S5P3(...)
#else
#define S5P1(...) s5_pass1(__VA_ARGS__)
#define S5P3(...) s5_pass3(__VA_ARGS__)
#endif
#ifdef NO_ATT0
#define ATT0(...)
#else
#define ATT0(...) attn_item<0, 128>(__VA_ARGS__)
#endif
#ifdef NO_ATT1
#define ATT1(...)
#else
#define ATT1(...) attn_item<1, 64>(__VA_ARGS__)
#endif
#ifdef NO_ATT2
#define ATT2(...)
#else
#define ATT2(...) attn_item<2, 128>(__VA_ARGS__)
#endif
#ifdef NO_GEMM
#define GEMM(...)
#else
#define GEMM(...) pg8::gemm_phase<__VA_ARGS__
#endif
DI int next_item_xcd(unsigned* ctrs, int nper, unsigned char* lds) {
    volatile int* si = (volatile int*)(lds + LDS_MISC);
    __syncthreads();
    if (threadIdx.x == 0) {
        const unsigned x0 = xb_xcc_id() & 7u; int res = -1;
        for (unsigned k = 0; k < 8u; ++k) { const unsigned q = (x0 + k) & 7u; if (xb_ld(&ctrs[q]) >= (unsigned)nper) continue; const unsigned v = xb_add(&ctrs[q], 1u); if (v < (unsigned)nper) { res = (int)(q * (unsigned)nper + v); break; } }
        *si = res;
    }
    __syncthreads();
    return *si;
}
__global__ void __launch_bounds__(512, 2) fwd_kernel(Params karg) {
    extern __shared__ __attribute__((aligned(16))) unsigned char lds[];
    cg::grid_group grid = cg::this_grid();
    {
        volatile unsigned* st = (volatile unsigned*)(lds + LDS_MISC + 16);
        if (threadIdx.x == 0) { st[0] = 0u; st[1] = 0u; }
        __syncthreads();
        KPtr p0 = launder_kp();
        if (p0->ws == nullptr) grid.sync();
        if (threadIdx.x == 0) (void)xb_add(&((unsigned*)(p0->ws + OFF_BAR))[XB_XCNT(xb_xcc_id())], 1u);
    }
#define GBAR() do { KPtr pb_ = launder_kp(); grid_barrier((unsigned*)(pb_->ws + OFF_BAR), (volatile unsigned*)(lds + LDS_MISC + 16)); } while (0)
#define PH_VARS KPtr p = launder_kp(); PG8_LAS unsigned char* l3 = (PG8_LAS unsigned char*)lds; const int G = osgpr(gridDim.x), c = osgpr(blockIdx.x); unsigned char* ws = p->ws; const char* xb = (const char*)(ws + OFF_XB); float* ssq = (float*)(ws + OFF_SSQ); unsigned* ctr = (unsigned*)(ws + OFF_SCAL) + 8; (void)l3; (void)G; (void)c; (void)xb; (void)ssq; (void)ctr;
    {
        PH_VARS
#ifndef NO_PREP
        phase_prep(p, lds);
#endif
    }
    GBAR();
    for (int f = 0; f < 4; ++f) {
        {
            PH_VARS
            pg8::Sched2 S{64, 22, 1408, 0, 0, 0, G, c, xb, (const char*)(ws + (size_t)f * SZ_FFN), nullptr, nullptr};
            EpiGateUp E{ssq, (bf16_t*)(ws + OFF_HID)}; rstd_cache_reset();
#if !defined(ONLY_G) || ONLY_G == 0
            pg8::gemm_phase<EpiGateUp, pg8::Sched2>(l3, 1024, S, E, nullptr);
#endif
        }
        GBAR();
        {
            PH_VARS
            pg8::Sched2 S{64, 4, 256, 0, 0, 0, G, c, (const char*)(ws + OFF_HID), (const char*)(ws + (size_t)f * SZ_FFN + SZ_WGU), nullptr, nullptr};
            EpiResid E{f == 0 ? p->in[0] : (const float*)nullptr, (bf16_t*)(ws + OFF_XB), ssq, 0.5f};
#if !defined(ONLY_G) || ONLY_G == 1
            pg8::gemm_phase<EpiResid, pg8::Sched2>(l3, FFH, S, E, nullptr);
#endif
        }
        GBAR();
        if (f == 0) {
            {
                PH_VARS
                pg8::Sched2 S{64, 6, 384, 2, 64, 128, G, c, xb, (const char*)(ws + OFF_WIN0), (const char*)(ws + OFF_WIN0 + (size_t)1536 * 1024 * 2), xb};
                EpiWin0 E{ssq, (bf16_t*)(ws + OFF_P0), (bf16_t*)(ws + OFF_VT0), (const f32x2*)(ws + OFF_ROPE)}; rstd_cache_reset();
#if !defined(ONLY_G) || ONLY_G == 2
                pg8::gemm_phase<EpiWin0, pg8::Sched2>(l3, 1024, S, E, nullptr);
#endif
            }
            GBAR();
            {
                PH_VARS
                for (;;) {
                    const int it = next_item_xcd(ctr + 0, 128, lds); if (it < 0) break;
                    const int x = it >> 7, j = it & 127;
                    const int s5lo = osgpr(32);
                    if (j >= s5lo && j < s5lo + 64) { S5P1(p, lds, x * 64 + (j - s5lo)); }
                    else { const int idx = j < s5lo ? j : j - 64; const int qblk = 31 - (idx >> 1), bh = 2 * x + (idx & 1); ATT0(p, lds, bh >> 2, bh & 3, qblk); }
                }
            }
            GBAR();
            {
                PH_VARS
                for (int it = c; it < 512; it += G) { S5P3(p, lds, it); }
            }
            GBAR();
            {
                PH_VARS
                pg8::Sched2 S{64, 2, 128, 0, 0, 0, G, c, (const char*)(ws + OFF_Z), (const char*)(ws + OFF_WGLU), nullptr, nullptr};
                EpiGLU E{(const bf16_t*)(ws + OFF_Z), p->in[21], (bf16_t*)(ws + OFF_YC0)};
#if !defined(ONLY_G) || ONLY_G == 3
                pg8::gemm_phase<EpiGLU, pg8::Sched2>(l3, 512, S, E, nullptr);
#endif
            }
            GBAR();
        }
        if (f == 2) {
            {
                PH_VARS
                pg8::Sched2 S{64, 8, 512, 4, 64, 256, G, c, xb, (const char*)(ws + OFF_WIN1), (const char*)(ws + OFF_WIN1 + (size_t)2304 * 1024 * 2), xb};
                EpiWin1 E{ssq, (bf16_t*)(ws + OFF_P1), (bf16_t*)(ws + OFF_VT1), (float*)(ws + OFF_GATES)}; rstd_cache_reset();
#if !defined(ONLY_G) || ONLY_G == 4
                pg8::gemm_phase<EpiWin1, pg8::Sched2>(l3, 1024, S, E, nullptr);
#endif
                gates_job(p);
            }
            GBAR();
            {
                PH_VARS
#ifndef NO_L1PREP
                phase_l1prep(p, lds);
#endif
            }
            GBAR();
            {
                PH_VARS
                for (;;) {
                    const int it = next_item_xcd(ctr + 8, 80, lds); if (it < 0) break;
                    const int x = it / 80, j = it % 80;
                    if (j < 16) { mlstm_local(p, lds, x * 16 + j); }
                    else { const int jj = j - 16, qblk = 15 - jj / 4, bh = 4 * x + (jj & 3); ATT1(p, lds, bh >> 3, bh & 7, qblk); }
                }
            }
            GBAR();
            {
                PH_VARS
                mlstm_prefix(p);
            }
            GBAR();
            {
                PH_VARS
                for (int it = c; it < 256; it += G) { const int bh = it & 15, qblk = it >> 4; attn_item<2, 128, true>(p, lds, bh >> 2, bh & 3, qblk); __syncthreads(); }
            }
            GBAR();
        }
        if (f == 0 || f == 2) {
            PH_VARS
            pg8::Sched2 S{64, 4, 256, 0, 0, 0, G, c, (const char*)(ws + (f == 0 ? OFF_YC0 : OFF_YC1)), (const char*)(ws + (f == 0 ? OFF_WOUT0 : OFF_WOUT1)), nullptr, nullptr};
            EpiResid E{(const float*)nullptr, (bf16_t*)(ws + OFF_XB), ssq, 1.0f};
#if !defined(ONLY_G) || ONLY_G == 5
            pg8::gemm_phase<EpiResid, pg8::Sched2>(l3, 1024, S, E, nullptr);
#endif
        }
        if (f == 0 || f == 2) GBAR();
    }
    {
        PH_VARS
        phase_final(p);
    }
}

extern "C" void kernel_launch(void* const* d_in, const int* in_sizes, int n_in, void* d_out, int out_size, void* d_ws, size_t ws_size, hipStream_t stream) {
    static int grid_blocks = 0;
    if (!grid_blocks) {
        int dev = 0, cus = 0, per_cu = 0;
        (void)hipGetDevice(&dev);
        (void)hipDeviceGetAttribute(&cus, hipDeviceAttributeMultiprocessorCount, dev);
        (void)hipFuncSetAttribute((const void*)fwd_kernel, hipFuncAttributeMaxDynamicSharedMemorySize, LDS_BYTES);
        (void)hipOccupancyMaxActiveBlocksPerMultiprocessor(&per_cu, (const void*)fwd_kernel, 512, LDS_BYTES);
        if (per_cu < 1) per_cu = 1;
        grid_blocks = cus * per_cu;
        if (n_in != 45 || ws_size < WS_END) fprintf(stderr, "kernel_launch: unexpected n_in %d / ws %zu\n", n_in, ws_size);
    }
    Params p{};
    for (int i = 0; i < 45; ++i) p.in[i] = (const float*)d_in[i];
    p.out = (float*)d_out; p.ws = (unsigned char*)d_ws;
    for (int i = 0; i < 8; ++i) p.inv_freq[i] = (float)pow(500000.0, -(double)(2 * i) / 16.0);
    (void)hipMemsetAsync((unsigned char*)d_ws + OFF_BAR, 0, BAR_BYTES, stream);
    void* args[] = {&p};
    hipError_t e = hipLaunchCooperativeKernel((const void*)fwd_kernel, dim3(grid_blocks), dim3(512), args, LDS_BYTES, stream);
    if (e != hipSuccess) fprintf(stderr, "cooperative launch failed: %s (grid %d)\n", hipGetErrorString(e), grid_blocks);
}
```

```cpp
#include <hip/hip_runtime.h>
#include <hip/hip_cooperative_groups.h>
#include <cstdio>
#include <cmath>
namespace cg = cooperative_groups;

#define PG8_LAS __attribute__((address_space(3)))
#define DI __device__ __forceinline__
typedef unsigned short bf16_t;
typedef short bf16x8 __attribute__((ext_vector_type(8)));
typedef float f32x4 __attribute__((ext_vector_type(4)));
typedef float f32x2 __attribute__((ext_vector_type(2)));
typedef float f32x16 __attribute__((ext_vector_type(16)));
typedef unsigned u32x4 __attribute__((ext_vector_type(4)));
typedef unsigned u32x2 __attribute__((ext_vector_type(2)));
typedef __bf16 bf16x2n __attribute__((ext_vector_type(2)));

constexpr int MT = 16384, DM = 1024, SEQ = 4096, FFH = 2816;
constexpr float LOG2E = 1.4426950408889634f;
constexpr float NEPS = 1e-6f;

constexpr size_t SZ_WGU = (size_t)5632 * 1024 * 2, SZ_WD = (size_t)1024 * 2816 * 2, SZ_FFN = SZ_WGU + SZ_WD;
constexpr size_t OFF_WIN0 = 4 * SZ_FFN;
constexpr size_t OFF_WGLU = OFF_WIN0 + (size_t)2048 * 1024 * 2;
constexpr size_t OFF_WOUT0 = OFF_WGLU + (size_t)512 * 512 * 2;
constexpr size_t OFF_WIN1 = OFF_WOUT0 + (size_t)1024 * 1024 * 2;
constexpr size_t OFF_WOUT1 = OFF_WIN1 + (size_t)3328 * 1024 * 2;
constexpr size_t OFF_XB = OFF_WOUT1 + (size_t)1024 * 1024 * 2;
constexpr size_t OFF_SSQ = OFF_XB + (size_t)MT * 1024 * 2;
constexpr size_t OFF_ROPE = OFF_SSQ + (size_t)16 * MT * 4;
constexpr size_t OFF_GATES = OFF_ROPE + (size_t)4096 * 8 * 8;
constexpr size_t OFF_MA = OFF_GATES + (size_t)MT * 16 * 4;
constexpr size_t OFF_MM = OFF_MA + (size_t)16 * 4096 * 4;
constexpr size_t OFF_MTT = OFF_MM + (size_t)16 * 4096 * 4;
constexpr size_t OFF_FF = OFF_MTT + (size_t)16 * 4096 * 4;
constexpr size_t OFF_S5E = OFF_FF + (size_t)32 * 4096 * 4;
constexpr size_t OFF_SCAL = OFF_S5E + (size_t)128 * 32 * 64 * 8;
constexpr size_t OFF_BAR = OFF_SCAL + 256;
constexpr size_t BAR_BYTES = 16384;
constexpr size_t OFF_U = OFF_BAR + BAR_BYTES;
constexpr size_t OFF_HID = OFF_U;
constexpr size_t OFF_P0 = OFF_U, OFF_VT0 = OFF_P0 + (size_t)MT * 1536 * 2, OFF_YC0 = OFF_VT0 + (size_t)512 * MT * 2, OFF_Z = OFF_YC0 + (size_t)MT * 1024 * 2;
constexpr size_t OFF_P1 = OFF_U, OFF_VT1 = OFF_P1 + (size_t)MT * 2048 * 2, OFF_YC1 = OFF_VT1 + (size_t)1024 * MT * 2;
constexpr size_t WS_END = OFF_YC1 + (size_t)MT * 1024 * 2;
static_assert(WS_END <= (size_t)256 * 1024 * 1024, "workspace");
static_assert(OFF_Z + (size_t)MT * 512 * 2 <= WS_END, "workspace L0");

constexpr int LDS_BYTES = 131072 + 1024 + 4352;
constexpr int LDS_RSTD = 131072 + 1024;
constexpr int LDS_MISC = 131072;

struct Params { const float* in[45]; float* out; unsigned char* ws; float inv_freq[8]; };
typedef const __attribute__((address_space(4))) Params* KPtr;
DI int otid() { int t = threadIdx.x; asm volatile("" : "+v"(t)); return t; }
DI int osgpr(int v) { asm volatile("" : "+s"(v)); return v; }
DI KPtr launder_kp() { KPtr q = (KPtr)__builtin_amdgcn_kernarg_segment_ptr(); asm volatile("" : "+s"(q)); return q; }

DI bf16_t f2bf(float f) { unsigned u = __float_as_uint(f); u += 0x7fffu + ((u >> 16) & 1u); return (bf16_t)(u >> 16); }
DI float bf2f(bf16_t b) { return __uint_as_float(((unsigned)b) << 16); }
DI unsigned pack2(float a, float b) { f32x2 v = {a, b}; bf16x2n r = __builtin_convertvector(v, bf16x2n); return __builtin_bit_cast(unsigned, r); }
DI float bflo(unsigned w) { return __uint_as_float(w << 16); }
DI float bfhi(unsigned w) { return __uint_as_float(w & 0xffff0000u); }
DI float fast_rcp(float x) { return __builtin_amdgcn_rcpf(x); }
DI float fast_exp2(float x) { return __builtin_amdgcn_exp2f(x); }
DI float sigmoidf_(float x) { return fast_rcp(1.0f + __expf(-x)); }

namespace pg8 {
constexpr int BM = 256, BK = 64, HALF = 128, HTB = HALF * BK * 2, STAGE_BYTES = 8 * HTB, NXCD = 8, WGM = 8;
__host__ __device__ __forceinline__ int lds_byte(int r, int c) { const int st = (r >> 4) * 2 + (c >> 5), rr = r & 15, cc = c & 31, ob = rr * 64 + cc * 2; return st * 1024 + (ob ^ (((ob >> 9) & 1) << 5)); }
__host__ __device__ __forceinline__ void stage_rc(int b, int& R, int& C) { const int st = b / 1024, sb = b % 1024, swz = sb ^ (((sb >> 9) & 1) << 5); R = (st >> 1) * 16 + swz / 64; C = (st & 1) * 32 + (swz % 64) / 2; }
__host__ __device__ __forceinline__ int perm32(int rho) { const int n = rho >> 4, i = rho & 15; return 8 * (i >> 2) + 4 * n + (i & 3); }
struct Unit { int pm, pn, kind; };
DI void decode_unit(int L, int nM, int nN, int& pm, int& pn) {
    const int nwg = nM * nN; int wgid = L; { const int q = nwg / NXCD, r = nwg % NXCD, xcd = wgid % NXCD, off = wgid / NXCD; wgid = (xcd < r ? xcd * (q + 1) : r * (q + 1) + (xcd - r) * q) + off; }
    const int nig = WGM * nN, gid = wgid / nig, fm = gid * WGM, gsz = (nM - fm) < WGM ? (nM - fm) : WGM;
    pm = fm + ((wgid % nig) % gsz); pn = (wgid % nig) / gsz;
}
struct Sched2 {
    int n1M, n1N, n1, n2M, n2N, n2, G, c; const char *A1, *B1, *A2, *B2;
    DI bool next(int i, Unit& u) const {
        long L = (long)i * G + c;
        if (L < n1) { decode_unit((int)L, n1M, n1N, u.pm, u.pn); u.kind = 0; return true; }
        L -= n1;
        if (L < n2) { decode_unit((int)L, n2M, n2N, u.pm, u.pn); u.kind = 1; return true; }
        return false;
    }
    DI const char* aptr(const Unit& u, size_t tstep) const { return (u.kind ? A2 : A1) + (size_t)u.pm * tstep; }
    DI const char* bptr(const Unit& u, size_t tstep) const { return (u.kind ? B2 : B1) + (size_t)u.pn * tstep; }
    DI void a_ready(const Unit&) const {}
    DI void done(const Unit&) const {}
};
DI long long wall_clock64_() { return 0; }
#define wall_clock64 wall_clock64_
template <class Epi, class Sched, bool STAMP = false>
__device__ __forceinline__ void gemm_phase(PG8_LAS unsigned char* lds, const int Kdim, const Sched& S, const Epi& E, unsigned long long* stamps) {
    const int tid = otid(), wid = __builtin_amdgcn_readfirstlane(tid >> 6), lane = tid & 63, wr = wid >> 2, wc = wid & 3, fr = lane & 15, fq = lane >> 4;
    const int K = Kdim, nt = K / BK;
    int ts_lo = 0, ts_hi = 0, nts = 0; const unsigned long long rt_entry = STAMP ? (unsigned long long)wall_clock64() : 0ull;
#define PG8_STAMP() do { if (STAMP && wid == 0 && nts < 64) { const unsigned long long _c = (unsigned long long)clock64(); \
        ts_lo = (lane == nts) ? (int)(unsigned)_c : ts_lo; ts_hi = (lane == nts) ? (int)(unsigned)(_c >> 32) : ts_hi; ++nts; } } while (0)
    PG8_STAMP();
    unsigned voffA[2], voffB[2];
#pragma unroll
    for (int i = 0; i < 2; ++i) { int R, C; stage_rc(tid * 16 + i * 8192, R, C); const int Rb = Epi::PERM ? ((R & ~31) + perm32(R & 31)) : R;
        voffA[i] = (unsigned)(R * K + C) * 2u; voffB[i] = (unsigned)(Rb * K + C) * 2u; }
    const size_t kstep = (size_t)(BK * 2);
    const size_t hstep = (size_t)HALF * K * 2;
    const size_t tstep = 2 * hstep;
    const unsigned ldsw = (unsigned)wid * 1024u;
    const int aoff = lds_byte(wr * 64 + fr, fq * 8), boff = lds_byte(wc * 32 + fr, fq * 8);
#define PG8_SA(b, h) (((b) * 2 + (h)) * HTB)
#define PG8_SB(b, h) ((4 + (b) * 2 + (h)) * HTB)
#define PG8_STAGE(bufoff, gbase, voff) do { _Pragma("unroll") for (int _i = 0; _i < 2; ++_i) \
        __builtin_amdgcn_global_load_lds((const unsigned*)((const char*)(gbase) + (voff)[_i]), (PG8_LAS unsigned*)(lds + (bufoff) + ldsw + _i * 8192), 16, 0, 0); } while (0)
#define PG8_LDA(dst, b, h) do { _Pragma("unroll") for (int m = 0; m < 4; ++m) _Pragma("unroll") for (int k = 0; k < 2; ++k) dst[m][k] = *(const PG8_LAS bf16x8*)(lds + PG8_SA(b, h) + aoff + m * 2048 + k * 1024); } while (0)
#define PG8_LDB(dst, b, h) do { _Pragma("unroll") for (int n = 0; n < 2; ++n) _Pragma("unroll") for (int k = 0; k < 2; ++k) dst[n][k] = *(const PG8_LAS bf16x8*)(lds + PG8_SB(b, h) + boff + n * 2048 + k * 1024); } while (0)
#define PG8_MMA(ai, bj, At, Bt) do { __builtin_amdgcn_s_setprio(1); _Pragma("unroll") for (int m = 0; m < 4; ++m) _Pragma("unroll") for (int n = 0; n < 2; ++n) _Pragma("unroll") for (int k = 0; k < 2; ++k) \
        acc[ai][bj][m][n] = __builtin_amdgcn_mfma_f32_16x16x32_bf16(Bt[n][k], At[m][k], acc[ai][bj][m][n], 0, 0, 0); __builtin_amdgcn_s_setprio(0); } while (0)
#define PG8_WAIT_V(n) asm volatile("s_waitcnt vmcnt(" #n ")" ::: "memory")
#define PG8_WAIT_L(n) asm volatile("s_waitcnt lgkmcnt(" #n ")" ::: "memory")
#define PG8_BAR __builtin_amdgcn_s_barrier()
#define PG8_SCHED __builtin_amdgcn_sched_barrier(0)
    Unit cur, nxt; int ui = 0;
    if (!S.next(0, cur)) return;
    f32x4 acc[2][2][4][2];
#pragma unroll
    for (int a = 0; a < 2; ++a)
#pragma unroll
        for (int b = 0; b < 2; ++b)
#pragma unroll
            for (int m = 0; m < 4; ++m)
#pragma unroll
                for (int n = 0; n < 2; ++n) acc[a][b][m][n] = (f32x4){0.f, 0.f, 0.f, 0.f};
    bf16x8 At[4][2], B0[2][2], B1[2][2];
    const char* cA = S.aptr(cur, tstep); const char* cB = S.bptr(cur, tstep);
    S.a_ready(cur);
    PG8_STAGE(PG8_SB(0, 0), cB, voffB); PG8_STAGE(PG8_SA(0, 0), cA, voffA); PG8_STAGE(PG8_SB(0, 1), cB + hstep, voffB); PG8_STAGE(PG8_SA(0, 1), cA + hstep, voffA);
    if (wr == 1) PG8_BAR;
    PG8_WAIT_V(4); PG8_BAR;
    PG8_STAGE(PG8_SB(1, 0), cB + kstep, voffB); PG8_STAGE(PG8_SA(1, 0), cA + kstep, voffA); PG8_STAGE(PG8_SB(1, 1), cB + hstep + kstep, voffB);
    PG8_WAIT_V(6); PG8_BAR;
    PG8_STAMP();
    for (;;) {
        const bool has_next = S.next(ui + 1, nxt);
        const char* nA = has_next ? S.aptr(nxt, tstep) : cA; const char* nB = has_next ? S.bptr(nxt, tstep) : cB;
        for (int t = 0; t < nt; t += 2) {
            const bool last = (t == nt - 2);
            const char* a1 = cA + (size_t)(t + 1) * kstep;
            const char* a2 = last ? nA : cA + (size_t)(t + 2) * kstep; const char* b2 = last ? nB : cB + (size_t)(t + 2) * kstep;
            const char* a3 = a2 + kstep; const char* b3 = b2 + kstep;
            if (last && has_next) S.a_ready(nxt);
            PG8_LDB(B0, 0, 0); PG8_SCHED; PG8_LDA(At, 0, 0); PG8_STAGE(PG8_SA(1, 1), a1 + hstep, voffA);
            PG8_WAIT_L(8); PG8_BAR; PG8_WAIT_L(0); PG8_MMA(0, 0, At, B0); PG8_BAR; PG8_SCHED;
            PG8_LDB(B1, 0, 1); PG8_STAGE(PG8_SB(0, 0), b2, voffB);
            PG8_BAR; PG8_WAIT_L(0); PG8_MMA(0, 1, At, B1); PG8_BAR;
            PG8_LDA(At, 0, 1); PG8_STAGE(PG8_SA(0, 0), a2, voffA);
            PG8_BAR; PG8_WAIT_L(0); PG8_MMA(1, 0, At, B0); PG8_BAR; PG8_SCHED;
            PG8_STAGE(PG8_SB(0, 1), b2 + hstep, voffB);
            PG8_WAIT_V(6); PG8_BAR; PG8_MMA(1, 1, At, B1); PG8_BAR;
            PG8_LDB(B0, 1, 0); PG8_SCHED; PG8_LDA(At, 1, 0); PG8_STAGE(PG8_SA(0, 1), a2 + hstep, voffA);
            PG8_WAIT_L(8); PG8_BAR; PG8_WAIT_L(0); PG8_MMA(0, 0, At, B0); PG8_BAR; PG8_SCHED;
            PG8_LDB(B1, 1, 1); PG8_STAGE(PG8_SB(1, 0), b3, voffB);
            PG8_BAR; PG8_WAIT_L(0); PG8_MMA(0, 1, At, B1); PG8_BAR;
            PG8_LDA(At, 1, 1); PG8_STAGE(PG8_SA(1, 0), a3, voffA);
            PG8_BAR; PG8_WAIT_L(0); PG8_MMA(1, 0, At, B0); PG8_BAR; PG8_SCHED;
            PG8_STAGE(PG8_SB(1, 1), b3 + hstep, voffB);
            PG8_WAIT_V(6); PG8_BAR; PG8_MMA(1, 1, At, B1); PG8_BAR;
        }
        PG8_STAMP();
        if constexpr (!Epi::AFTER_DRAIN) { E(acc, cur, wr, wc, fr, fq); S.done(cur); }
        PG8_STAMP();
        if (!has_next) break;
#pragma unroll
        for (int a = 0; a < 2; ++a)
#pragma unroll
            for (int b = 0; b < 2; ++b)
#pragma unroll
                for (int m = 0; m < 4; ++m)
#pragma unroll
                    for (int n = 0; n < 2; ++n) acc[a][b][m][n] = (f32x4){0.f, 0.f, 0.f, 0.f};
        cur = nxt; cA = nA; cB = nB; ++ui;
    }
    PG8_WAIT_V(0);
    if (wr == 0) PG8_BAR;
    PG8_BAR;
    if constexpr (Epi::AFTER_DRAIN) { E.fused(acc, cur, wr, wc, fr, fq, lds, wid, lane); S.done(cur); }
    PG8_STAMP();
    if (STAMP && wid == 0) { stamps[lane] = lane < nts ? (((unsigned long long)(unsigned)ts_hi << 32) | (unsigned)ts_lo) : 0ull;
        if (lane == 62) stamps[62] = rt_entry; if (lane == 63) stamps[63] = (unsigned long long)wall_clock64(); }
#undef PG8_STAMP
#undef PG8_SA
#undef PG8_SB
#undef PG8_STAGE
#undef PG8_LDA
#undef PG8_LDB
#undef PG8_MMA
#undef PG8_WAIT_V
#undef PG8_WAIT_L
#undef PG8_BAR
#undef PG8_SCHED
}
#undef wall_clock64
}
using pg8::Unit;
typedef f32x4 AccT[2][2][4][2];

DI void row_rstd(const float* ssq, int row0, int fq, float (&rs)[2][4]) {
#pragma unroll
    for (int ai = 0; ai < 2; ++ai)
#pragma unroll
        for (int m = 0; m < 4; ++m) {
            const int row = row0 + ai * 128 + m * 16; float s = 0.f;
#pragma unroll
            for (int q = 0; q < 4; ++q) s += ssq[(size_t)(4 * fq + q) * MT + row];
            s += __shfl_xor(s, 16); s += __shfl_xor(s, 32);
            rs[ai][m] = rsqrtf(s * (1.0f / 1024.0f) + NEPS);
        }
}
DI void row_rstd_cached(const float* ssq, int tag, int row0, int wave, int fr, int fq, float (&rs)[2][4]) {
    PG8_LAS float* tab = (PG8_LAS float*)(unsigned)(LDS_RSTD + wave * 544); volatile PG8_LAS int* tagp = (volatile PG8_LAS int*)(unsigned)(LDS_RSTD + wave * 544 + 512);
    if (*tagp != tag) {
#pragma unroll
        for (int ai = 0; ai < 2; ++ai)
#pragma unroll
            for (int m = 0; m < 4; ++m) {
                const int row = row0 + ai * 128 + m * 16; float sq = 0.f;
#pragma unroll
                for (int q = 0; q < 4; ++q) sq += ssq[(size_t)(4 * fq + q) * MT + row];
                sq += __shfl_xor(sq, 16); sq += __shfl_xor(sq, 32);
                if (fq == 0) tab[(ai * 4 + m) * 16 + fr] = rsqrtf(sq * (1.0f / 1024.0f) + NEPS);
            }
        if (fr == 0 && fq == 0) *tagp = tag;
        asm volatile("s_waitcnt lgkmcnt(0)" ::: "memory");
    }
#pragma unroll
    for (int ai = 0; ai < 2; ++ai)
#pragma unroll
        for (int m = 0; m < 4; ++m) rs[ai][m] = tab[(ai * 4 + m) * 16 + fr];
}
DI void rstd_cache_reset() { const int t = otid(); if ((t & 63) == 0) *(volatile PG8_LAS int*)(unsigned)(LDS_RSTD + (t >> 6) * 544 + 512) = -1; }
DI u32x4 pack8(const f32x4& a, const f32x4& b) { u32x4 w; w.x = pack2(a[0], a[1]); w.y = pack2(a[2], a[3]); w.z = pack2(b[0], b[1]); w.w = pack2(b[2], b[3]); return w; }
DI void epi_vt(const AccT& acc, const Unit& u, int wr, int wc, int fr, int fq, const float* ssq, bf16_t* vt) {
    const int tokb = u.pn * 256 + wc * 32 + 8 * fq;
    f32x4 rt[2][2];
#pragma unroll
    for (int bj = 0; bj < 2; ++bj)
#pragma unroll
        for (int n = 0; n < 2; ++n) {
            f32x4 s = *(const f32x4*)(ssq + (size_t)fr * MT + tokb + bj * 128 + n * 4);
#pragma unroll
            for (int off = 1; off < 16; off <<= 1) { s[0] += __shfl_xor(s[0], off); s[1] += __shfl_xor(s[1], off); s[2] += __shfl_xor(s[2], off); s[3] += __shfl_xor(s[3], off); }
#pragma unroll
            for (int j = 0; j < 4; ++j) s[j] = rsqrtf(s[j] * (1.0f / 1024.0f) + NEPS);
            rt[bj][n] = s;
        }
#pragma unroll
    for (int ai = 0; ai < 2; ++ai)
#pragma unroll
        for (int m = 0; m < 4; ++m) {
            const int row = u.pm * 256 + ai * 128 + wr * 64 + m * 16 + fr;
#pragma unroll
            for (int bj = 0; bj < 2; ++bj) {
                const f32x4 v0 = acc[ai][bj][m][0] * rt[bj][0], v1 = acc[ai][bj][m][1] * rt[bj][1];
                *(u32x4*)(vt + (size_t)row * MT + tokb + bj * 128) = pack8(v0, v1);
            }
        }
}

struct EpiGateUp {
    static constexpr bool PERM = true, AFTER_DRAIN = false;
    const float* ssq; bf16_t* hid;
    DI void operator()(const AccT& acc, const Unit& u, int wr, int wc, int fr, int fq) const {
        const int row0 = u.pm * 256 + wr * 64 + fr; float rs[2][4]; row_rstd_cached(ssq, u.pm, row0, wr * 4 + wc, fr, fq, rs);
        const int colh = u.pn * 128 + wc * 32 + 8 * fq;
#pragma unroll
        for (int ai = 0; ai < 2; ++ai)
#pragma unroll
            for (int m = 0; m < 4; ++m) {
                const float r = rs[ai][m]; f32x4 h0, h1;
#pragma unroll
                for (int j = 0; j < 4; ++j) {
                    const float g0 = acc[ai][0][m][0][j] * r, g1 = acc[ai][0][m][1][j] * r, u0 = acc[ai][1][m][0][j] * r, u1 = acc[ai][1][m][1][j] * r;
                    h0[j] = g0 * sigmoidf_(g0) * u0; h1[j] = g1 * sigmoidf_(g1) * u1;
                }
                *(u32x4*)(hid + (size_t)(row0 + ai * 128 + m * 16) * FFH + colh) = pack8(h0, h1);
            }
    }
};
struct EpiResid {
    static constexpr bool PERM = false, AFTER_DRAIN = false;
    const float* xin32; bf16_t* xb; float* ssq; float scale;
    DI void operator()(const AccT& acc, const Unit& u, int wr, int wc, int fr, int fq) const {
        const int row0 = u.pm * 256 + wr * 64 + fr, col0 = u.pn * 256 + wc * 32 + 4 * fq;
#pragma unroll
        for (int ai = 0; ai < 2; ++ai)
#pragma unroll
            for (int m = 0; m < 4; ++m) {
                const int row = row0 + ai * 128 + m * 16; float ss = 0.f;
#pragma unroll
                for (int bj = 0; bj < 2; ++bj)
#pragma unroll
                    for (int n = 0; n < 2; ++n) {
                        const size_t o = (size_t)row * DM + col0 + bj * 128 + n * 16;
                        f32x4 xr;
                        if (xin32) xr = *(const f32x4*)(xin32 + o);
                        else { const u32x2 w0 = *(const u32x2*)(xb + o); xr[0] = bflo(w0.x); xr[1] = bfhi(w0.x); xr[2] = bflo(w0.y); xr[3] = bfhi(w0.y); }
                        const f32x4 xn = xr + acc[ai][bj][m][n] * scale;
                        u32x2 w; w.x = pack2(xn[0], xn[1]); w.y = pack2(xn[2], xn[3]); *(u32x2*)(xb + o) = w;
                        ss += (xn[0] * xn[0] + xn[1] * xn[1]) + (xn[2] * xn[2] + xn[3] * xn[3]);
                    }
                ss += __shfl_xor(ss, 16); ss += __shfl_xor(ss, 32);
                if (fq == 0) ssq[(size_t)(4 * u.pn + wc) * MT + row] = ss;
            }
    }
};
struct EpiWin0 {
    static constexpr bool PERM = true, AFTER_DRAIN = false;
    const float* ssq; bf16_t* p0; bf16_t* vt; const f32x2* rope;
    DI void operator()(const AccT& acc, const Unit& u, int wr, int wc, int fr, int fq) const {
        if (u.kind) { epi_vt(acc, u, wr, wc, fr, fq, ssq, vt); return; }
        const int row0 = u.pm * 256 + wr * 64 + fr; float rs[2][4]; row_rstd_cached(ssq, u.pm, row0, wr * 4 + wc, fr, fq, rs);
        const bool rot = (u.pn < 4) && !(wc & 1) && (fq < 2);
#pragma unroll
        for (int ai = 0; ai < 2; ++ai)
#pragma unroll
            for (int m = 0; m < 4; ++m) {
                const int row = row0 + ai * 128 + m * 16; const float r = rs[ai][m]; const int pos = row & (SEQ - 1);
#pragma unroll
                for (int bj = 0; bj < 2; ++bj) {
                    f32x4 v0 = acc[ai][bj][m][0] * r, v1 = acc[ai][bj][m][1] * r;
                    if (rot) {
                        const f32x2* tb = rope + pos * 8 + 4 * fq;
#pragma unroll
                        for (int j = 0; j < 4; ++j) { const f32x2 cs = tb[j]; const float x1 = v0[j], x2 = v1[j]; v0[j] = x1 * cs.x - x2 * cs.y; v1[j] = x2 * cs.x + x1 * cs.y; }
                    }
                    *(u32x4*)(p0 + (size_t)row * 1536 + u.pn * 256 + bj * 128 + wc * 32 + 8 * fq) = pack8(v0, v1);
                }
            }
    }
};
struct EpiWin1 {
    static constexpr bool PERM = true, AFTER_DRAIN = false;
    const float* ssq; bf16_t* p1; bf16_t* vt; float* gates;
    DI void operator()(const AccT& acc, const Unit& u, int wr, int wc, int fr, int fq) const {
        if (u.kind) { epi_vt(acc, u, wr, wc, fr, fq, ssq, vt); return; }
        const int row0 = u.pm * 256 + wr * 64 + fr; float rs[2][4]; row_rstd_cached(ssq, u.pm, row0, wr * 4 + wc, fr, fq, rs);
#pragma unroll
        for (int ai = 0; ai < 2; ++ai)
#pragma unroll
            for (int m = 0; m < 4; ++m) {
                const int row = row0 + ai * 128 + m * 16; const float r = rs[ai][m];
                if (u.pn < 8) {
#pragma unroll
                    for (int bj = 0; bj < 2; ++bj) {
                        const f32x4 v0 = acc[ai][bj][m][0] * r, v1 = acc[ai][bj][m][1] * r;
                        *(u32x4*)(p1 + (size_t)row * 2048 + u.pn * 256 + bj * 128 + wc * 32 + 8 * fq) = pack8(v0, v1);
                    }
                } else if (wc == 0 && fq < 2) {
                    *(f32x4*)(gates + (size_t)row * 16 + 8 * fq) = acc[ai][0][m][0] * r;
                    *(f32x4*)(gates + (size_t)row * 16 + 8 * fq + 4) = acc[ai][0][m][1] * r;
                }
            }
    }
};
struct EpiGLU {
    static constexpr bool PERM = true, AFTER_DRAIN = false;
    const bf16_t* z; const float* bias; bf16_t* ycat;
    DI void operator()(const AccT& acc, const Unit& u, int wr, int wc, int fr, int fq) const {
        const int row0 = u.pm * 256 + wr * 64 + fr, colb = u.pn * 256 + wc * 32 + 8 * fq;
#pragma unroll
        for (int bj = 0; bj < 2; ++bj) {
            const int col = colb + bj * 128;
            const f32x4 b0 = *(const f32x4*)(bias + col), b1 = *(const f32x4*)(bias + col + 4);
#pragma unroll
            for (int ai = 0; ai < 2; ++ai)
#pragma unroll
                for (int m = 0; m < 4; ++m) {
                    const int row = row0 + ai * 128 + m * 16;
                    const u32x4 zz = *(const u32x4*)(z + (size_t)row * 512 + col);
                    const f32x4 g0 = acc[ai][bj][m][0] + b0, g1 = acc[ai][bj][m][1] + b1; f32x4 o0, o1;
                    o0[0] = bflo(zz.x) * sigmoidf_(g0[0]); o0[1] = bfhi(zz.x) * sigmoidf_(g0[1]); o0[2] = bflo(zz.y) * sigmoidf_(g0[2]); o0[3] = bfhi(zz.y) * sigmoidf_(g0[3]);
                    o1[0] = bflo(zz.z) * sigmoidf_(g1[0]); o1[1] = bfhi(zz.z) * sigmoidf_(g1[1]); o1[2] = bflo(zz.w) * sigmoidf_(g1[2]); o1[3] = bfhi(zz.w) * sigmoidf_(g1[3]);
                    *(u32x4*)(ycat + (size_t)row * 1024 + 512 + col) = pack8(o0, o1);
                }
        }
    }
};

struct Job { const float* W; const float* W2; const float* gain; bf16_t* dst; int K, ldw, nrows, kind; };
DI int ffn_base(int f) { return f == 0 ? 1 : (f == 1 ? 23 : (f == 2 ? 27 : 40)); }
DI Job get_job(KPtr p, int j) {
    Job J; J.W2 = nullptr; J.gain = nullptr; J.kind = 0;
    if (j < 4) { const int nb = ffn_base(j); J.W = p->in[nb + 1]; J.W2 = p->in[nb + 2]; J.gain = p->in[nb]; J.dst = (bf16_t*)(p->ws + (size_t)j * SZ_FFN); J.K = 1024; J.ldw = FFH; J.nrows = 5632; J.kind = 1; }
    else if (j < 8) { const int nb = ffn_base(j - 4); J.W = p->in[nb + 3]; J.dst = (bf16_t*)(p->ws + (size_t)(j - 4) * SZ_FFN + SZ_WGU); J.K = FFH; J.ldw = 1024; J.nrows = 1024; }
    else if (j == 8) { J.W = p->in[6]; J.gain = p->in[5]; J.dst = (bf16_t*)(p->ws + OFF_WIN0); J.K = 1024; J.ldw = 2048; J.nrows = 2048; J.kind = 2; }
    else if (j == 9) { J.W = p->in[20]; J.dst = (bf16_t*)(p->ws + OFF_WGLU); J.K = 512; J.ldw = 512; J.nrows = 512; }
    else if (j == 10) { J.W = p->in[22]; J.dst = (bf16_t*)(p->ws + OFF_WOUT0); J.K = 1024; J.ldw = 1024; J.nrows = 1024; }
    else if (j == 11) { J.W = p->in[32]; J.gain = p->in[31]; J.dst = (bf16_t*)(p->ws + OFF_WIN1); J.K = 1024; J.ldw = 3088; J.nrows = 3328; J.kind = 3; }
    else { J.W = p->in[39]; J.dst = (bf16_t*)(p->ws + OFF_WOUT1); J.K = 1024; J.ldw = 1024; J.nrows = 1024; }
    return J;
}
DI int job_tiles(int j) { return j < 4 ? 176 : (j < 8 ? 88 : (j == 8 ? 64 : (j == 9 ? 8 : (j == 11 ? 104 : 32)))); }
DI int map_col(int kind, int n, bool& w2) {
    w2 = false;
    if (kind == 0) return n;
    if (kind == 1) { w2 = (n >> 7) & 1; return (n >> 8) * 128 + (n & 127); }
    if (kind == 2) {
        if (n < 1024) { const int pos = n & 63, base = n - pos; int lg = pos; if (pos < 16) lg = pos < 8 ? (pos < 4 ? pos : pos + 4) : (pos < 12 ? pos - 4 : pos); return base + lg; }
        if (n < 1536) return 1536 + (n - 1024);
        return 1024 + (n - 1536);
    }
    if (n < 512) return n;
    if (n < 1024) return 1032 + (n - 512);
    if (n < 1536) return 1544 + (n - 1024);
    if (n < 2048) return 2056 + (n - 1536);
    if (n < 2304) { const int j = n - 2048; return j < 4 ? 1024 : (j < 8 ? 1028 : (j < 16 ? 3080 + (j - 8) : -1)); }
    if (n < 2816) return 512 + (n - 2304);
    return 2568 + (n - 2816);
}
DI void phase_prep(KPtr p, unsigned char* lds) {
    const int tid = otid(), lane = tid & 63, wid = tid >> 6;
    if (blockIdx.x == 0 && wid == 0) {
        float s1 = p->in[7][lane] * p->in[8][lane], s2 = p->in[9][lane] * p->in[10][lane];
#pragma unroll
        for (int off = 1; off < 64; off <<= 1) { s1 += __shfl_xor(s1, off); s2 += __shfl_xor(s2, off); }
        if (lane == 0) { float* sc = (float*)(p->ws + OFF_SCAL); sc[0] = expf(s1) - expf(s2) + 0.2f; }
        if (lane < 48) ((unsigned*)(p->ws + OFF_SCAL) + 8)[lane] = 0u;
    }
    for (int idx = blockIdx.x * 512 + tid; idx < 4096 * 8; idx += gridDim.x * 512) {
        const int pos = idx >> 3, i = idx & 7; float fi = p->inv_freq[0];
        fi = i == 1 ? p->inv_freq[1] : fi; fi = i == 2 ? p->inv_freq[2] : fi; fi = i == 3 ? p->inv_freq[3] : fi; fi = i == 4 ? p->inv_freq[4] : fi; fi = i == 5 ? p->inv_freq[5] : fi; fi = i == 6 ? p->inv_freq[6] : fi; fi = i == 7 ? p->inv_freq[7] : fi;
        const float angf = (float)pos * fi; const double a = (double)angf; const double kk = rint(a * 0.15915494309189535); const double r = a - kk * 6.283185307179586;
        const float fr = (float)(r * 0.15915494309189535);
        f32x2 cs; cs.x = __builtin_amdgcn_cosf(fr); cs.y = __builtin_amdgcn_sinf(fr);
        ((f32x2*)(p->ws + OFF_ROPE))[idx] = cs;
    }
    {
        const float* x = p->in[0]; bf16_t* xb = (bf16_t*)(p->ws + OFF_XB); float* ssq = (float*)(p->ws + OFF_SSQ);
        const int rstride = gridDim.x * 8;
        for (int row0 = blockIdx.x * 8 + wid; row0 < MT; row0 += 4 * rstride) {
            f32x4 v[4][4];
#pragma unroll
            for (int rr = 0; rr < 4; ++rr) { const int row = row0 + rr * rstride;
#pragma unroll
                for (int i = 0; i < 4; ++i) v[rr][i] = row < MT ? *(const f32x4*)(x + (size_t)row * DM + i * 256 + lane * 4) : (f32x4){0.f, 0.f, 0.f, 0.f}; }
#pragma unroll
            for (int rr = 0; rr < 4; ++rr) { const int row = row0 + rr * rstride; if (row >= MT) break;
                float ss = 0.f;
#pragma unroll
                for (int i = 0; i < 4; ++i) { const size_t o = (size_t)row * DM + i * 256 + lane * 4; const f32x4 q = v[rr][i];
                    u32x2 w; w.x = pack2(q[0], q[1]); w.y = pack2(q[2], q[3]); *(u32x2*)(xb + o) = w; ss += (q[0] * q[0] + q[1] * q[1]) + (q[2] * q[2] + q[3] * q[3]); }
#pragma unroll
                for (int off = 1; off < 64; off <<= 1) ss += __shfl_xor(ss, off);
                if (lane < 16) ssq[(size_t)lane * MT + row] = lane == 0 ? ss : 0.f;
            }
        }
    }
    bf16_t* T = (bf16_t*)lds;
    for (int t = blockIdx.x; t < 1296; t += gridDim.x) {
        int j = 0, tt = t; while (tt >= job_tiles(j)) { tt -= job_tiles(j); ++j; }
        const Job J = get_job(p, j); const int nkt = J.K >> 7; const int n0 = (tt / nkt) * 256, k0 = (tt % nkt) * 128;
        const int nq = tid & 63, kr = tid >> 6; bool w2; const int sc = map_col(J.kind, n0 + 4 * nq, w2); const float* Ws = w2 ? J.W2 : J.W;
        f32x4 v[16]; float gk[16];
#pragma unroll
        for (int i = 0; i < 16; ++i) { const int k = k0 + kr + 8 * i; v[i] = sc >= 0 ? *(const f32x4*)(Ws + (size_t)k * J.ldw + sc) : (f32x4){0.f, 0.f, 0.f, 0.f}; gk[i] = J.gain ? J.gain[k] : 1.0f; }
#pragma unroll
        for (int i = 0; i < 16; ++i) { const int kl = kr + 8 * i;
#pragma unroll
            for (int e = 0; e < 4; ++e) T[(4 * nq + e) * 130 + kl] = f2bf(v[i][e] * gk[i]); }
        __syncthreads();
        { const int n = tid >> 1, ks = tid & 1; const unsigned* src = (const unsigned*)(T + n * 130 + 64 * ks); bf16_t* d = J.dst + (size_t)(n0 + n) * J.K + k0 + 64 * ks;
#pragma unroll
          for (int q = 0; q < 8; ++q) { u32x4 w; w.x = src[4 * q]; w.y = src[4 * q + 1]; w.z = src[4 * q + 2]; w.w = src[4 * q + 3]; *(u32x4*)(d + 8 * q) = w; } }
        __syncthreads();
    }
}
#define MFMA32(a, b, c) __builtin_amdgcn_mfma_f32_32x32x16_bf16((a), (b), (c), 0, 0, 0)
#define MFMA16(a, b, c) __builtin_amdgcn_mfma_f32_16x16x32_bf16((a), (b), (c), 0, 0, 0)
constexpr int AT_GRP = 26880, AT_V = 9216, AT_S = 26624;
template <int MODE, int DV, bool CH = false>
DI void attn_item(KPtr p, unsigned char* ldsb, int b, int hp, int qblk) {
    constexpr int NDB = DV / 32;
    const int tid = otid(), lane = tid & 63, wid = tid >> 6, g = wid >> 2, w = wid & 3, r = lane & 31, h = lane >> 5, tg = tid & 255;
    constexpr bool SH = (MODE != 0);
    constexpr int NKC = SH ? 1 : 2, NVC = DV / 64, LSTR = SH ? 512 : 256;
    constexpr bool VFO = (MODE != 2);
    constexpr int BSTR = SH ? 2 * AT_GRP : 36864;
    const int tl = SH ? tid : tg;
    const int tok0 = b * SEQ, head = hp;
    const bf16_t *Qb, *Kb, *Vt; int ld; const float* ksc = nullptr;
    if (MODE == 0) { const bf16_t* P0 = (const bf16_t*)(p->ws + OFF_P0); Qb = P0 + hp * 128 + g * 64; Kb = P0 + 512 + hp * 128 + g * 64; ld = 1536; Vt = (const bf16_t*)(p->ws + OFF_VT0) + (size_t)(hp * 128) * MT; }
    else if (MODE == 1) { const bf16_t* P1 = (const bf16_t*)(p->ws + OFF_P1); Qb = P1 + 1024 + head * 64; Kb = P1 + 1536 + head * 64; ld = 2048; Vt = (const bf16_t*)(p->ws + OFF_VT1) + (size_t)(512 + head * 64) * MT; ksc = (const float*)(p->ws + OFF_FF) + (size_t)(b * 8 + head) * SEQ; }
    else { const bf16_t* QK = (const bf16_t*)p->out; Qb = QK + head * 64; Kb = QK + 256 + head * 64; ld = 512; Vt = (const bf16_t*)(p->ws + OFF_VT1) + (size_t)(head * 128) * MT; ksc = (const float*)(p->ws + OFF_MA) + (size_t)(b * 4 + head) * SEQ; }
    unsigned char* Kl = ldsb + (SH ? 0 : g * 9216); unsigned char* Vl = ldsb + (SH ? AT_V : 18432);
    const int qpos = SH ? 256 * qblk + 128 * g + 32 * w + r : 128 * qblk + 32 * w + r; const size_t tq = (size_t)tok0 + qpos;
    bf16x8 qf[4];
#pragma unroll
    for (int ks = 0; ks < 4; ++ks) qf[ks] = *(const bf16x8*)(Qb + tq * ld + 16 * ks + 8 * h);
    float Fref = 0.f, Mlq = 0.f, mtq = 0.f;
    if (MODE == 1) Fref = ksc[256 * qblk];
    if (MODE == 2) Mlq = ((const float*)(p->ws + OFF_MM))[(size_t)(b * 4 + head) * SEQ + qpos];
    f32x16 O[NDB];
#pragma unroll
    for (int d = 0; d < NDB; ++d)
#pragma unroll
        for (int i = 0; i < 16; ++i) O[d][i] = 0.f;
    float m_run = -1e30f, lsum = 0.f;
    const int nkt = SH ? 4 * (qblk + 1) : 2 * (qblk + 1), ktmax = SH ? 4 * qblk + 2 * g + (w >> 1) : 2 * qblk + (w >> 1), kdiag = SH ? 4 * qblk + 2 * g : 2 * qblk;
    u32x4 kreg[NKC], vreg[NVC]; float sreg = 0.f;
#define AT_LOAD(kt_) do { const size_t key0 = (size_t)tok0 + 64 * (kt_); \
        _Pragma("unroll") for (int i_ = 0; i_ < NKC; ++i_) { const int c_ = tl + LSTR * i_; kreg[i_] = *(const u32x4*)(Kb + (key0 + (c_ >> 3)) * ld + (c_ & 7) * 8); } \
        _Pragma("unroll") for (int i_ = 0; i_ < NVC; ++i_) { const int c_ = tid + 512 * i_; vreg[i_] = *(const u32x4*)(Vt + (size_t)(c_ >> 3) * MT + key0 + (c_ & 7) * 8); } \
        if (MODE != 0 && tl < 64) sreg = ksc[64 * (kt_) + tl]; } while (0)
#define AT_STORE(buf_) do { unsigned char* Kd_ = Kl + (buf_) * BSTR; unsigned char* Vd_ = Vl + (buf_) * BSTR; \
        _Pragma("unroll") for (int i_ = 0; i_ < NKC; ++i_) { const int c_ = tl + LSTR * i_; *(u32x4*)(Kd_ + (c_ >> 3) * 144 + (c_ & 7) * 16) = kreg[i_]; } \
        _Pragma("unroll") for (int i_ = 0; i_ < NVC; ++i_) { const int c_ = tid + 512 * i_; unsigned char* d_ = VFO ? Vd_ + (c_ >> 3) * 144 + ((c_ & 7) >> 1) * 32 + (c_ & 1) * 8 : Vd_ + (c_ >> 3) * 136 + (c_ & 7) * 16; u32x2 lo_, hi_; lo_.x = vreg[i_].x; lo_.y = vreg[i_].y; hi_.x = vreg[i_].z; hi_.y = vreg[i_].w; *(u32x2*)d_ = lo_; *(u32x2*)(d_ + (VFO ? 16 : 8)) = hi_; } \
        if (MODE != 0 && tl < 64) ((float*)(Kd_ + AT_S))[tl] = (MODE == 1) ? (Fref - sreg) * 8.0f : sreg; } while (0)
    const int kt0 = CH ? 4 * qblk : 0;
    AT_LOAD(kt0);
    AT_STORE(0);
    if (kt0 + 1 < nkt) AT_LOAD(kt0 + 1);
    __syncthreads();
    for (int kt = kt0; kt < nkt; ++kt) {
        const int cur = (kt - kt0) & 1;
        if (kt + 1 < nkt) AT_STORE(cur ^ 1);
        if (kt + 2 < nkt) AT_LOAD(kt + 2);
        unsigned char* const Kc = Kl + cur * BSTR; unsigned char* const Vc = Vl + cur * BSTR; float* const Sc = (float*)(Kc + AT_S);
        if (CH ? (kt == ktmax) : (kt <= ktmax)) {
            const bool diag = kt >= kdiag;
            bf16x8 kf[2][4]; f32x4 sv[2][4];
#pragma unroll
            for (int kb = 0; kb < 2; ++kb)
#pragma unroll
                for (int ks = 0; ks < 4; ++ks) kf[kb][ks] = *(const bf16x8*)(Kc + (32 * kb + r) * 144 + 32 * ks + 16 * h);
            if (MODE != 0) {
#pragma unroll
                for (int kb = 0; kb < 2; ++kb)
#pragma unroll
                    for (int gq = 0; gq < 4; ++gq) sv[kb][gq] = *(const f32x4*)(Sc + 32 * kb + 8 * gq + 4 * h);
            }
            __builtin_amdgcn_sched_barrier(0);
            f32x16 sacc[2];
#pragma unroll
            for (int kb = 0; kb < 2; ++kb) {
                if (MODE == 1) {
#pragma unroll
                    for (int gq = 0; gq < 4; ++gq) { sacc[kb][4 * gq] = sv[kb][gq][0]; sacc[kb][4 * gq + 1] = sv[kb][gq][1]; sacc[kb][4 * gq + 2] = sv[kb][gq][2]; sacc[kb][4 * gq + 3] = sv[kb][gq][3]; }
                } else {
#pragma unroll
                    for (int i = 0; i < 16; ++i) sacc[kb][i] = 0.f;
                }
            }
#pragma unroll
            for (int ks = 0; ks < 4; ++ks)
#pragma unroll
                for (int kb = 0; kb < 2; ++kb) sacc[kb] = MFMA32(kf[kb][ks], qf[ks], sacc[kb]);
            u32x4 vf0[2][2][2];
#pragma unroll
            for (int d = 0; d < 2; ++d)
#pragma unroll
                for (int kb = 0; kb < 2; ++kb)
#pragma unroll
                    for (int s2 = 0; s2 < 2; ++s2) {
                        if (VFO) vf0[d][kb][s2] = *(const u32x4*)(Vc + (32 * d + r) * 144 + (32 * kb + 16 * s2) * 2 + 16 * h);
                        else { const unsigned char* va = Vc + (32 * d + r) * 136 + (32 * kb + 16 * s2 + 4 * h) * 2;
                        const u32x2 lo = *(const u32x2*)va, hi = *(const u32x2*)(va + 16); vf0[d][kb][s2].x = lo.x; vf0[d][kb][s2].y = lo.y; vf0[d][kb][s2].z = hi.x; vf0[d][kb][s2].w = hi.y; }
                    }
            __builtin_amdgcn_sched_barrier(0);
            if (MODE != 2) {
                const float c = 0.125f * LOG2E;
                if (diag) {
#pragma unroll
                    for (int kb = 0; kb < 2; ++kb)
#pragma unroll
                        for (int i = 0; i < 16; ++i) { const int key = 64 * kt + 32 * kb + (i & 3) + 8 * (i >> 2) + 4 * h; if (key > qpos) sacc[kb][i] = -1e30f; }
                }
                float mx = -1e30f;
#pragma unroll
                for (int kb = 0; kb < 2; ++kb)
#pragma unroll
                    for (int i = 0; i < 16; ++i) mx = fmaxf(mx, sacc[kb][i]);
                mx = fmaxf(mx, __shfl_xor(mx, 32));
                const float m_new = fmaxf(m_run, mx), alpha = fast_exp2((m_run - m_new) * c), mc = m_new * c;
                m_run = m_new; lsum *= alpha;
                if (__builtin_amdgcn_ballot_w64(alpha != 1.0f) != 0ull) {
#pragma unroll
                    for (int d = 0; d < NDB; ++d)
#pragma unroll
                        for (int i = 0; i < 16; ++i) O[d][i] *= alpha;
                }
#pragma unroll
                for (int kb = 0; kb < 2; ++kb)
#pragma unroll
                    for (int i = 0; i < 16; ++i) { const float pv = fast_exp2(sacc[kb][i] * c - mc); lsum += pv; sacc[kb][i] = pv; }
            } else {
#pragma unroll
                for (int kb = 0; kb < 2; ++kb)
#pragma unroll
                    for (int gq = 0; gq < 4; ++gq) {
#pragma unroll
                        for (int e = 0; e < 4; ++e) {
                            const int i = 4 * gq + e; float val = sacc[kb][i] * fast_exp2(sv[kb][gq][e] - Mlq);
                            if (diag) { const int key = 64 * kt + 32 * kb + 8 * gq + 4 * h + e; if (key > qpos) val = 0.f; }
                            lsum += val; sacc[kb][i] = val;
                        }
                    }
            }
            bf16x8 P[2][2];
#pragma unroll
            for (int kb = 0; kb < 2; ++kb)
#pragma unroll
                for (int s2 = 0; s2 < 2; ++s2) { u32x4 pk; pk.x = pack2(sacc[kb][8 * s2], sacc[kb][8 * s2 + 1]); pk.y = pack2(sacc[kb][8 * s2 + 2], sacc[kb][8 * s2 + 3]); pk.z = pack2(sacc[kb][8 * s2 + 4], sacc[kb][8 * s2 + 5]); pk.w = pack2(sacc[kb][8 * s2 + 6], sacc[kb][8 * s2 + 7]); P[kb][s2] = __builtin_bit_cast(bf16x8, pk); }
            u32x4 vf1[2][2][2];
            if (NDB == 4) {
#pragma unroll
                for (int d = 0; d < 2; ++d)
#pragma unroll
                    for (int kb = 0; kb < 2; ++kb)
#pragma unroll
                        for (int s2 = 0; s2 < 2; ++s2) {
                            if (VFO) vf1[d][kb][s2] = *(const u32x4*)(Vc + (32 * (d + 2) + r) * 144 + (32 * kb + 16 * s2) * 2 + 16 * h);
                            else { const unsigned char* va = Vc + (32 * (d + 2) + r) * 136 + (32 * kb + 16 * s2 + 4 * h) * 2;
                            const u32x2 lo = *(const u32x2*)va, hi = *(const u32x2*)(va + 16); vf1[d][kb][s2].x = lo.x; vf1[d][kb][s2].y = lo.y; vf1[d][kb][s2].z = hi.x; vf1[d][kb][s2].w = hi.y; }
                        }
            }
            __builtin_amdgcn_sched_barrier(0);
#pragma unroll
            for (int kb = 0; kb < 2; ++kb)
#pragma unroll
                for (int s2 = 0; s2 < 2; ++s2)
#pragma unroll
                    for (int d = 0; d < 2; ++d) O[d] = MFMA32(__builtin_bit_cast(bf16x8, vf0[d][kb][s2]), P[kb][s2], O[d]);
            if (NDB == 4) {
#pragma unroll
                for (int kb = 0; kb < 2; ++kb)
#pragma unroll
                    for (int s2 = 0; s2 < 2; ++s2)
#pragma unroll
                        for (int d = 0; d < 2; ++d) O[d + 2] = MFMA32(__builtin_bit_cast(bf16x8, vf1[d][kb][s2]), P[kb][s2], O[d + 2]);
            }
        }
        __syncthreads();
    }
#undef AT_STORE
#undef AT_LOAD
    if (CH && MODE == 2 && ktmax > 0) {
        const int bh = b * 4 + head; const bf16_t* LCp = (const bf16_t*)p->out + (size_t)8 * 1024 * 1024 + ((size_t)(bh * 64 + ktmax - 1) * 160) * 64;
        const float sc = fast_exp2(((const float*)(p->ws + OFF_MM))[(size_t)bh * SEQ + 64 * ktmax - 1] - Mlq);
#pragma unroll
        for (int db = 0; db < 5; ++db) {
            f32x16 I;
#pragma unroll
            for (int i = 0; i < 16; ++i) I[i] = 0.f;
#pragma unroll
            for (int ks = 0; ks < 4; ++ks) { const bf16x8 af = *(const bf16x8*)(LCp + (size_t)(32 * db + r) * 64 + 16 * ks + 8 * h); I = MFMA32(af, qf[ks], I); }
            if (db < 4) {
#pragma unroll
                for (int i = 0; i < 16; ++i) O[db < 4 ? db : 0][i] += I[i] * sc;
            } else if (h == 0) lsum += I[0] * sc;
        }
    }
    lsum += __shfl_xor(lsum, 32);
    if (MODE == 1) {
        const float inv = 1.0f / lsum; bf16_t* yc = (bf16_t*)(p->ws + OFF_YC1) + tq * 1024 + 512 + head * 64;
#pragma unroll
        for (int d = 0; d < NDB; ++d)
#pragma unroll
            for (int gq = 0; gq < 4; ++gq) { u32x2 wv; wv.x = pack2(O[d][4 * gq] * inv, O[d][4 * gq + 1] * inv); wv.y = pack2(O[d][4 * gq + 2] * inv, O[d][4 * gq + 3] * inv); *(u32x2*)(yc + 32 * d + 8 * gq + 4 * h) = wv; }
    } else if (MODE == 2) {
        mtq = ((const float*)(p->ws + OFF_MTT))[(size_t)(b * 4 + head) * SEQ + qpos];
        const float dd = fmaxf(fabsf(lsum), expf(-mtq)), inv = 1.0f / dd; float ss = 0.f;
#pragma unroll
        for (int d = 0; d < NDB; ++d)
#pragma unroll
            for (int i = 0; i < 16; ++i) { O[d][i] *= inv; ss += O[d][i] * O[d][i]; }
        ss += __shfl_xor(ss, 32);
        const float rstd = rsqrtf(ss * (1.0f / 128.0f) + NEPS);
        const bf16_t* og = (const bf16_t*)(p->ws + OFF_P1) + tq * 2048 + 512 + head * 128; const float* gn = p->in[37] + head * 128;
        bf16_t* yc = (bf16_t*)(p->ws + OFF_YC1) + tq * 1024 + head * 128;
#pragma unroll
        for (int d = 0; d < NDB; ++d)
#pragma unroll
            for (int gq = 0; gq < 4; ++gq) {
                const int dv = 32 * d + 8 * gq + 4 * h; const u32x2 ow = *(const u32x2*)(og + dv); const f32x4 gv = *(const f32x4*)(gn + dv);
                const float o0 = O[d][4 * gq] * rstd * gv[0] * sigmoidf_(bflo(ow.x)), o1 = O[d][4 * gq + 1] * rstd * gv[1] * sigmoidf_(bfhi(ow.x));
                const float o2 = O[d][4 * gq + 2] * rstd * gv[2] * sigmoidf_(bflo(ow.y)), o3 = O[d][4 * gq + 3] * rstd * gv[3] * sigmoidf_(bfhi(ow.y));
                u32x2 wv; wv.x = pack2(o0, o1); wv.y = pack2(o2, o3); *(u32x2*)(yc + dv) = wv;
            }
    } else {
        const float inv = 1.0f / lsum; float* X = (float*)ldsb;
        __syncthreads();
        if (g == 1) {
#pragma unroll
            for (int d = 0; d < NDB; ++d)
#pragma unroll
                for (int i = 0; i < 16; ++i) X[(32 * d + (i & 3) + 8 * (i >> 2) + 4 * h) * 128 + 32 * w + r] = O[d][i] * inv;
        }
        __syncthreads();
        if (g == 0) {
            const float lam = ((const float*)(p->ws + OFF_SCAL))[0]; float ss = 0.f;
#pragma unroll
            for (int d = 0; d < NDB; ++d)
#pragma unroll
                for (int i = 0; i < 16; ++i) { const float v = O[d][i] * inv - lam * X[(32 * d + (i & 3) + 8 * (i >> 2) + 4 * h) * 128 + 32 * w + r]; O[d][i] = v; ss += v * v; }
            ss += __shfl_xor(ss, 32);
            const float rstd = rsqrtf(ss * (1.0f / 128.0f) + NEPS) * 0.8f; const float* gn = p->in[11];
            bf16_t* yc = (bf16_t*)(p->ws + OFF_YC0) + tq * 1024 + hp * 128;
#pragma unroll
            for (int d = 0; d < NDB; ++d)
#pragma unroll
                for (int gq = 0; gq < 4; ++gq) {
                    const int dv = 32 * d + 8 * gq + 4 * h; const f32x4 gv = *(const f32x4*)(gn + dv);
                    u32x2 wv; wv.x = pack2(O[d][4 * gq] * rstd * gv[0], O[d][4 * gq + 1] * rstd * gv[1]); wv.y = pack2(O[d][4 * gq + 2] * rstd * gv[2], O[d][4 * gq + 3] * rstd * gv[3]); *(u32x2*)(yc + dv) = wv;
                }
        }
    }
}

DI void mlstm_local(KPtr p, unsigned char* lds, int item_) {
    const int tid_ = otid(); const int lane = tid_ & 63, wid = __builtin_amdgcn_readfirstlane(tid_ >> 6); const int item = __builtin_amdgcn_readfirstlane(item_);
    const int bh = item >> 3, c = (item & 7) * 8 + wid, b = bh >> 2, head = bh & 3, r = lane & 31, h = lane >> 5;
    const size_t tok0 = (size_t)b * SEQ + c * 64;
    const float* mA = (const float*)(p->ws + OFF_MA) + (size_t)bh * SEQ + c * 64; const float mend = ((const float*)(p->ws + OFF_MM))[(size_t)bh * SEQ + c * 64 + 63];
    const bf16_t* Kg = (const bf16_t*)p->out + tok0 * 512 + 256 + head * 64;
    unsigned char* Kl = lds + wid * 9216;
    __syncthreads();
#pragma unroll
    for (int i = 0; i < 8; ++i) {
        const int cc = lane + 64 * i, row = cc >> 3, part = cc & 7; const u32x4 kv = *(const u32x4*)(Kg + (size_t)row * 512 + part * 8); const float wgt = fast_exp2(mA[row] - mend);
        u32x4 o; o.x = pack2(bflo(kv.x) * wgt, bfhi(kv.x) * wgt); o.y = pack2(bflo(kv.y) * wgt, bfhi(kv.y) * wgt); o.z = pack2(bflo(kv.z) * wgt, bfhi(kv.z) * wgt); o.w = pack2(bflo(kv.w) * wgt, bfhi(kv.w) * wgt);
        *(u32x4*)(Kl + row * 144 + part * 16) = o;
    }
    asm volatile("s_waitcnt lgkmcnt(0)" ::: "memory");
    bf16x8 bfr[2][4];
#pragma unroll
    for (int nb = 0; nb < 2; ++nb)
#pragma unroll
        for (int ks = 0; ks < 4; ++ks)
#pragma unroll
            for (int j = 0; j < 8; ++j) bfr[nb][ks][j] = (short)*(const bf16_t*)(Kl + (16 * ks + 8 * h + j) * 144 + (32 * nb + r) * 2);
    const bf16_t* Vt = (const bf16_t*)(p->ws + OFF_VT1) + (size_t)(head * 128) * MT + tok0;
    bf16_t* LC = (bf16_t*)p->out + (size_t)8 * 1024 * 1024 + ((size_t)(bh * 64 + c) * 160) * 64;
#pragma unroll 1
    for (int db = 0; db < 5; ++db) {
        bf16x8 af[4];
        if (db < 4) {
#pragma unroll
            for (int ks = 0; ks < 4; ++ks) af[ks] = *(const bf16x8*)(Vt + (size_t)(32 * db + r) * MT + 16 * ks + 8 * h);
        } else {
            const short one = (r == 0) ? (short)0x3F80 : (short)0;
#pragma unroll
            for (int ks = 0; ks < 4; ++ks)
#pragma unroll
                for (int j = 0; j < 8; ++j) af[ks][j] = one;
        }
#pragma unroll
        for (int nb = 0; nb < 2; ++nb) {
            f32x16 acc;
#pragma unroll
            for (int i = 0; i < 16; ++i) acc[i] = 0.f;
#pragma unroll
            for (int ks = 0; ks < 4; ++ks) acc = MFMA32(af[ks], bfr[nb][ks], acc);
#pragma unroll
            for (int i = 0; i < 16; ++i) LC[(size_t)(32 * db + (i & 3) + 8 * (i >> 2) + 4 * h) * 64 + 32 * nb + r] = f2bf(acc[i]);
        }
    }
}
DI void mlstm_prefix(KPtr p) {
    const int tid = otid(); const float* mM = (const float*)(p->ws + OFF_MM);
    for (int idx = blockIdx.x * 512 + tid; idx < 16 * 5120; idx += gridDim.x * 512) {
        const int bh = idx / 5120, e = idx % 5120;
        unsigned* base = (unsigned*)((bf16_t*)p->out + (size_t)8 * 1024 * 1024) + (size_t)bh * 64 * 5120 + e;
        const float* mMb = mM + (size_t)bh * SEQ; float c0 = 0.f, c1 = 0.f;
#pragma unroll 1
        for (int hb = 0; hb < 2; ++hb) {
            unsigned wv[32]; float gd[32];
#pragma unroll
            for (int i = 0; i < 32; ++i) { const int c = hb * 32 + i; wv[i] = base[(size_t)c * 5120]; gd[i] = c == 0 ? 0.f : fast_exp2(mMb[64 * c - 1] - mMb[64 * c + 63]); }
#pragma unroll
            for (int i = 0; i < 32; ++i) { c0 = gd[i] * c0 + bflo(wv[i]); c1 = gd[i] * c1 + bfhi(wv[i]); wv[i] = pack2(c0, c1); }
#pragma unroll
            for (int i = 0; i < 32; ++i) base[(size_t)(hb * 32 + i) * 5120] = wv[i];
        }
    }
}

DI void s5_consts(KPtr p, int g, int lane, float& ar, float& ai, unsigned (&bbr)[8], unsigned (&bbi)[8]) {
    const float lr = p->in[12][g * 64 + lane], li = p->in[13][g * 64 + lane], dt = expf(p->in[14][g]);
    const float mag = expf(lr * dt); ar = mag * cosf(li * dt); ai = mag * sinf(li * dt);
    const float den = lr * lr + li * li, gr = ((ar - 1.0f) * lr + ai * li) / den, gi = (ai * lr - (ar - 1.0f) * li) / den;
    const f32x4* br4 = (const f32x4*)(p->in[15] + (size_t)(g * 64 + lane) * 16); const f32x4* bi4 = (const f32x4*)(p->in[16] + (size_t)(g * 64 + lane) * 16);
#pragma unroll
    for (int q = 0; q < 4; ++q) { const f32x4 br = br4[q], bi = bi4[q];
        bbr[2 * q] = pack2(gr * br[0] - gi * bi[0], gr * br[1] - gi * bi[1]); bbr[2 * q + 1] = pack2(gr * br[2] - gi * bi[2], gr * br[3] - gi * bi[3]);
        bbi[2 * q] = pack2(gr * bi[0] + gi * br[0], gr * bi[1] + gi * br[1]); bbi[2 * q + 1] = pack2(gr * bi[2] + gi * br[2], gr * bi[3] + gi * br[3]); }
}
constexpr int S5_X = 34816, S5_XW = 8448, S5_BT = 102400;
DI void s5_setup(KPtr p, unsigned char* lds, int g, int lane, float& ar, float& ai, bf16x8 (&bfr)[8]) {
    unsigned bbr[8], bbi[8]; s5_consts(p, g, lane, ar, ai, bbr, bbi);
    __syncthreads();
    u32x4* bt = (u32x4*)(lds + S5_BT); u32x4 w;
    w.x = bbr[0]; w.y = bbr[1]; w.z = bbr[2]; w.w = bbr[3]; bt[lane * 2] = w; w.x = bbr[4]; w.y = bbr[5]; w.z = bbr[6]; w.w = bbr[7]; bt[lane * 2 + 1] = w;
    w.x = bbi[0]; w.y = bbi[1]; w.z = bbi[2]; w.w = bbi[3]; bt[(64 + lane) * 2] = w; w.x = bbi[4]; w.y = bbi[5]; w.z = bbi[6]; w.w = bbi[7]; bt[(64 + lane) * 2 + 1] = w;
    __syncthreads();
    const int col = lane & 15, quad = lane >> 4;
#pragma unroll
    for (int nb = 0; nb < 8; ++nb) bfr[nb] = *(const bf16x8*)(lds + S5_BT + ((16 * nb + col) * 16 + 8 * (quad & 1)) * 2);
}
#define S5_XBLOCK(a_) do { const f32x4 z4_ = {0.f, 0.f, 0.f, 0.f}; \
        _Pragma("unroll") for (int nb_ = 0; nb_ < 8; ++nb_) { const f32x4 d_ = MFMA16((a_), bfr[nb_], z4_); \
            _Pragma("unroll") for (int j_ = 0; j_ < 4; ++j_) Xw[(4 * quad + j_) * 132 + 16 * nb_ + col] = d_[j_]; } \
        asm volatile("s_waitcnt lgkmcnt(0)" ::: "memory"); } while (0)
DI void s5_pass1(KPtr p, unsigned char* lds, int item_) {
    const int tid_ = otid(); const int lane = tid_ & 63, wid = __builtin_amdgcn_readfirstlane(tid_ >> 6); const int item = __builtin_amdgcn_readfirstlane(item_);
    const int bg = item >> 2, b = bg >> 5, g = bg & 31, c = (item & 3) * 8 + wid, col = lane & 15, quad = lane >> 4;
    float ar, ai; bf16x8 bfr[8]; s5_setup(p, lds, g, lane, ar, ai, bfr);
    float* Xw = (float*)(lds + S5_X + wid * S5_XW);
    const bf16_t* ub = (const bf16_t*)(p->ws + OFF_P0) + (size_t)(b * SEQ + c * 128 + col) * 1536 + 1024 + g * 16 + 8 * (quad & 1);
    const bf16x8 zero8 = {0, 0, 0, 0, 0, 0, 0, 0};
    float hr = 0.f, hi = 0.f;
    bf16x8 an = quad < 2 ? *(const bf16x8*)ub : zero8;
#pragma unroll 1
    for (int blk = 0; blk < 8; ++blk) {
        const bf16x8 a = an; if (blk < 7) an = quad < 2 ? *(const bf16x8*)(ub + (size_t)16 * (blk + 1) * 1536) : zero8;
        S5_XBLOCK(a);
#pragma unroll
        for (int tt = 0; tt < 16; ++tt) { const float xr = Xw[tt * 132 + lane], xi = Xw[tt * 132 + 64 + lane]; const float nr = ar * hr - ai * hi + xr, ni = ar * hi + ai * hr + xi; hr = nr; hi = ni; }
        asm volatile("s_waitcnt lgkmcnt(0)" ::: "memory");
    }
    f32x2 e; e.x = hr; e.y = hi; ((f32x2*)(p->ws + OFF_S5E))[((size_t)bg * 32 + c) * 64 + lane] = e;
}
DI void s5_pass3(KPtr p, unsigned char* lds, int item_) {
    const int tid_ = otid(); const int lane = tid_ & 63, wid = __builtin_amdgcn_readfirstlane(tid_ >> 6); const int item = __builtin_amdgcn_readfirstlane(item_);
    const int bg = item >> 2, b = bg >> 5, g = bg & 31, c = (item & 3) * 8 + wid, col = lane & 15, quad = lane >> 4;
    float ar, ai; bf16x8 bfr[8]; s5_setup(p, lds, g, lane, ar, ai, bfr);
    float pr = ar, pi = ai;
#pragma unroll
    for (int i = 0; i < 7; ++i) { const float t = pr * pr - pi * pi; pi = 2.0f * pr * pi; pr = t; }
    float hr = 0.f, hi = 0.f; const f32x2* E = (const f32x2*)(p->ws + OFF_S5E) + (size_t)bg * 32 * 64 + lane;
#pragma unroll 8
    for (int cc = 0; cc < 32; ++cc) {
        const bool on = cc < c; f32x2 e = {0.f, 0.f}; if (on) e = E[cc * 64];
        const float qr = on ? pr : 1.0f, qi = on ? pi : 0.0f;
        const float nr = qr * hr - qi * hi + e.x, ni = qr * hi + qi * hr + e.y; hr = nr; hi = ni;
    }
    const int hh = col;
    bf16x8 cb[4];
#pragma unroll
    for (int ks = 0; ks < 4; ++ks)
#pragma unroll
        for (int j = 0; j < 8; ++j) { const int k = 32 * ks + 8 * quad + j, sp = k >> 1; const float v = (k & 1) ? -p->in[18][(size_t)(g * 16 + hh) * 64 + sp] : p->in[17][(size_t)(g * 16 + hh) * 64 + sp]; cb[ks][j] = (short)f2bf(v); }
    const float dsk = p->in[19][g * 16 + hh];
    const bf16_t* P0 = (const bf16_t*)(p->ws + OFF_P0); bf16_t* Z = (bf16_t*)(p->ws + OFF_Z); const int tokb = b * SEQ + c * 128;
    bf16_t* Hs = (bf16_t*)(lds + wid * 4352);
    float* Xw = (float*)(lds + S5_X + wid * S5_XW);
    const bf16_t* ub = P0 + (size_t)(tokb + col) * 1536 + 1024 + g * 16 + 8 * (quad & 1);
    const bf16x8 zero8 = {0, 0, 0, 0, 0, 0, 0, 0};
    bf16x8 an = quad < 2 ? *(const bf16x8*)ub : zero8;
#pragma unroll 1
    for (int blk = 0; blk < 8; ++blk) {
        const bf16x8 a = an; if (blk < 7) an = quad < 2 ? *(const bf16x8*)(ub + (size_t)16 * (blk + 1) * 1536) : zero8;
        bf16_t uu4[4];
#pragma unroll
        for (int j = 0; j < 4; ++j) uu4[j] = P0[((size_t)tokb + blk * 16 + 4 * quad + j) * 1536 + 1024 + g * 16 + hh];
        S5_XBLOCK(a);
#pragma unroll
        for (int tt = 0; tt < 16; ++tt) {
            const float xr = Xw[tt * 132 + lane], xi = Xw[tt * 132 + 64 + lane]; const float nr = ar * hr - ai * hi + xr, ni = ar * hi + ai * hr + xi; hr = nr; hi = ni;
            *(unsigned*)(Hs + tt * 136 + 2 * lane) = pack2(hr, hi);
        }
        asm volatile("s_waitcnt lgkmcnt(0)" ::: "memory");
        f32x4 acc = {0.f, 0.f, 0.f, 0.f};
#pragma unroll
        for (int ks = 0; ks < 4; ++ks) { const bf16x8 af = *(const bf16x8*)(Hs + hh * 136 + 32 * ks + 8 * quad); acc = MFMA16(af, cb[ks], acc); }
        asm volatile("s_waitcnt lgkmcnt(0)" ::: "memory");
#pragma unroll
        for (int j = 0; j < 4; ++j) {
            const size_t tok = (size_t)tokb + blk * 16 + 4 * quad + j; const float uu = bf2f(uu4[j]);
            const float y = acc[j] + dsk * uu; const float zz = y * sigmoidf_(1.5957691216057308f * (y + 0.044715f * y * y * y));
            Z[tok * 512 + g * 16 + hh] = f2bf(zz);
        }
    }
}
#undef S5_XBLOCK

DI void gates_job(KPtr p) {
    const int tid = otid(), lane = tid & 63, wid = __builtin_amdgcn_readfirstlane(tid >> 6), r16 = lane & 15, quad = lane >> 4;
    const bf16_t* xb = (const bf16_t*)(p->ws + OFF_XB); const bf16_t* Wg = (const bf16_t*)(p->ws + OFF_WIN1) + (size_t)2048 * 1024;
    const float* ssq = (const float*)(p->ws + OFF_SSQ); float* gates = (float*)(p->ws + OFF_GATES);
    for (int tb = blockIdx.x * 8 + wid; tb < MT / 16; tb += gridDim.x * 8) {
        const int t0 = tb * 16;
        const bf16_t* ap = xb + (size_t)(t0 + r16) * 1024 + 8 * quad; const bf16_t* bp = Wg + (size_t)r16 * 1024 + 8 * quad;
        f32x4 acc = {0.f, 0.f, 0.f, 0.f};
#pragma unroll 1
        for (int k8 = 0; k8 < 4; ++k8) {
            bf16x8 a[8], b[8];
#pragma unroll
            for (int i = 0; i < 8; ++i) { a[i] = *(const bf16x8*)(ap + 32 * (8 * k8 + i)); b[i] = *(const bf16x8*)(bp + 32 * (8 * k8 + i)); }
#pragma unroll
            for (int i = 0; i < 8; ++i) acc = MFMA16(a[i], b[i], acc);
        }
        f32x4 sq = *(const f32x4*)(ssq + (size_t)r16 * MT + t0 + 4 * quad);
#pragma unroll
        for (int off = 1; off < 16; off <<= 1) { sq[0] += __shfl_xor(sq[0], off); sq[1] += __shfl_xor(sq[1], off); sq[2] += __shfl_xor(sq[2], off); sq[3] += __shfl_xor(sq[3], off); }
        { f32x4 gv;
#pragma unroll
          for (int j = 0; j < 4; ++j) gv[j] = acc[j] * rsqrtf(sq[j] * (1.0f / 1024.0f) + NEPS); *(f32x4*)(gates + (size_t)r16 * MT + t0 + 4 * quad) = gv; }
    }
}

DI float logsig(float x) { return fminf(x, 0.f) - log1pf(expf(-fabsf(x))); }
DI void phase_l1prep(KPtr p, unsigned char* lds) {
    const int tid = otid(), lane = tid & 63, wid = tid >> 6;
    const bf16_t* P1 = (const bf16_t*)(p->ws + OFF_P1); bf16_t* QK = (bf16_t*)p->out; const float* G = (const float*)(p->ws + OFF_GATES);
    const int nscan = gridDim.x > 96 ? 48 : 0;
    if ((int)blockIdx.x < 48) {
        const int task = blockIdx.x; const bool ml = task < 16; const int t2 = ml ? task : task - 16; const int b = ml ? (t2 >> 2) : (t2 >> 3), hh = ml ? (t2 & 3) : (t2 & 7);
        const float bfv = ml ? p->in[36][hh] : p->in[38][hh], biv = ml ? p->in[35][hh] : 0.f; const int fcol = ml ? 4 + hh : 8 + hh, icol = hh;
        float* fF = (float*)(p->ws + OFF_FF) + (size_t)t2 * SEQ; float* mA = (float*)(p->ws + OFF_MA) + (size_t)t2 * SEQ; float* mM = (float*)(p->ws + OFF_MM) + (size_t)t2 * SEQ; float* mT = (float*)(p->ws + OFF_MTT) + (size_t)t2 * SEQ;
        double* shd = (double*)lds; float* shm = (float*)(lds + 64);
        const int pos0 = wid * 512 + lane; const float* Gf = G + (size_t)fcol * MT + (size_t)b * SEQ + pos0; const float* Gi = G + (size_t)icol * MT + (size_t)b * SEQ + pos0;
        float v[8], ig[8];
#pragma unroll
        for (int ch = 0; ch < 8; ++ch) { v[ch] = logsig(Gf[ch * 64] + bfv); ig[ch] = ml ? Gi[ch * 64] + biv : 0.f; }
#pragma unroll
        for (int off = 1; off < 64; off <<= 1) {
#pragma unroll
            for (int ch = 0; ch < 8; ++ch) { const float t = __shfl_up(v[ch], off); if (lane >= off) v[ch] += t; }
        }
        double Fl[8]; double Fc = 0.0;
#pragma unroll
        for (int ch = 0; ch < 8; ++ch) { const float tot = __shfl(v[ch], 63); Fl[ch] = Fc + (double)v[ch]; Fc += (double)tot; }
        __syncthreads();
        if (lane == 0) shd[wid] = Fc;
        __syncthreads();
        double base = 0.0;
        for (int w2 = 0; w2 < wid; ++w2) base += shd[w2];
        float Fv[8];
#pragma unroll
        for (int ch = 0; ch < 8; ++ch) Fv[ch] = (float)(base + Fl[ch]);
        if (!ml) {
#pragma unroll
            for (int ch = 0; ch < 8; ++ch) fF[pos0 + ch * 64] = Fv[ch];
        } else {
            float a[8], cm[8];
#pragma unroll
            for (int ch = 0; ch < 8; ++ch) { a[ch] = ig[ch] - Fv[ch]; cm[ch] = a[ch]; mA[pos0 + ch * 64] = a[ch] * LOG2E; }
#pragma unroll
            for (int off = 1; off < 64; off <<= 1) {
#pragma unroll
                for (int ch = 0; ch < 8; ++ch) { const float t = __shfl_up(cm[ch], off); if (lane >= off) cm[ch] = fmaxf(cm[ch], t); }
            }
            float Mc = -3.0e38f; float Ml[8];
#pragma unroll
            for (int ch = 0; ch < 8; ++ch) { const float tot = __shfl(cm[ch], 63); Ml[ch] = fmaxf(Mc, cm[ch]); Mc = fmaxf(Mc, tot); }
            if (lane == 0) shm[wid] = Mc;
            __syncthreads();
            float bm = 0.f;
            for (int w2 = 0; w2 < wid; ++w2) bm = fmaxf(bm, shm[w2]);
#pragma unroll
            for (int ch = 0; ch < 8; ++ch) { const float Mr = fmaxf(bm, Ml[ch]); mM[pos0 + ch * 64] = Mr * LOG2E; mT[pos0 + ch * 64] = Fv[ch] + Mr; }
        }
    }
    const float* cw = p->in[33]; const float* cbv = p->in[34];
    if ((int)blockIdx.x >= nscan)
    for (int idx = ((int)blockIdx.x - nscan) * 512 + tid; idx < MT * 64; idx += ((int)gridDim.x - nscan) * 512) {
        const int tok = idx >> 6, c8 = (idx & 63) * 8, pos = tok & (SEQ - 1);
        float acc[8];
#pragma unroll
        for (int e = 0; e < 8; ++e) acc[e] = cbv[c8 + e];
#pragma unroll
        for (int j = 0; j < 4; ++j) {
            if (pos - 3 + j >= 0) {
                const u32x4 xv = *(const u32x4*)(P1 + (size_t)(tok - 3 + j) * 2048 + c8); const f32x4 w0 = *(const f32x4*)(cw + j * 512 + c8), w1 = *(const f32x4*)(cw + j * 512 + c8 + 4);
                acc[0] += w0[0] * bflo(xv.x); acc[1] += w0[1] * bfhi(xv.x); acc[2] += w0[2] * bflo(xv.y); acc[3] += w0[3] * bfhi(xv.y);
                acc[4] += w1[0] * bflo(xv.z); acc[5] += w1[1] * bfhi(xv.z); acc[6] += w1[2] * bflo(xv.w); acc[7] += w1[3] * bfhi(xv.w);
            }
        }
        const float sc = c8 < 256 ? 0.125f : 1.0f;
#pragma unroll
        for (int e = 0; e < 8; ++e) acc[e] = acc[e] * sigmoidf_(acc[e]) * sc;
        u32x4 o; o.x = pack2(acc[0], acc[1]); o.y = pack2(acc[2], acc[3]); o.z = pack2(acc[4], acc[5]); o.w = pack2(acc[6], acc[7]);
        *(u32x4*)(QK + (size_t)tok * 512 + c8) = o;
    }
}

DI void phase_final(KPtr p) {
    const int tid_ = otid(); const int lane = tid_ & 63, wid = tid_ >> 6; const float* ssq = (const float*)(p->ws + OFF_SSQ); const float* gn = p->in[44]; float* out = p->out; const bf16_t* xbf = (const bf16_t*)(p->ws + OFF_XB);
    for (int row = blockIdx.x * 8 + wid; row < MT; row += gridDim.x * 8) {
        float s = lane < 16 ? ssq[(size_t)lane * MT + row] : 0.f;
#pragma unroll
        for (int off = 1; off < 16; off <<= 1) s += __shfl_xor(s, off);
        s = __shfl(s, 0);
        const float rstd = rsqrtf(s * (1.0f / 1024.0f) + NEPS);
#pragma unroll
        for (int i = 0; i < 4; ++i) { const size_t o = (size_t)row * DM + i * 256 + lane * 4; const u32x2 w0 = *(const u32x2*)(xbf + o); f32x4 v; v[0] = bflo(w0.x); v[1] = bfhi(w0.x); v[2] = bflo(w0.y); v[3] = bfhi(w0.y); const f32x4 gv = *(const f32x4*)(gn + i * 256 + lane * 4); *(f32x4*)(out + o) = v * gv * rstd; }
    }
}

#define XB_TMO      128
#define XB_XCNT(j)  (256  + 64 * (j))
#define XB_XSUB(j)  (1280 + 64 * (j))
#define XB_XGEN(j)  (2304 + 64 * (j))
#define XB_TOP      3328
#define XB_TOPGEN   3392
#define XB_SPIN_CAP (1u << 22)
DI unsigned xb_ld(unsigned* q) { return __hip_atomic_load(q, __ATOMIC_RELAXED, __HIP_MEMORY_SCOPE_AGENT); }
DI unsigned xb_add(unsigned* q, unsigned v) { return __hip_atomic_fetch_add(q, v, __ATOMIC_RELAXED, __HIP_MEMORY_SCOPE_AGENT); }
DI unsigned xb_xcc_id() { return (unsigned)__builtin_amdgcn_s_getreg((3 << 11) | 20) & 0xFu; }
#define XB_SPIN(cond, bar) do { unsigned _sp = 0; while (cond) { __builtin_amdgcn_s_sleep(1); \
    if ((++_sp & 255u) == 0u) { if (xb_ld(&(bar)[XB_TMO])) break; if (_sp > XB_SPIN_CAP) { atomicAdd(&(bar)[XB_TMO], 1u); break; } } } } while (0)
DI void xcd_barrier_complete(unsigned* bar, unsigned x, unsigned& nloc, unsigned& nx) {
    const unsigned G = gridDim.x; unsigned sum, cnt, mine, sp = 0u;
    for (;;) {
        sum = 0u; cnt = 0u; mine = 0u;
#pragma unroll
        for (unsigned j = 0; j < 16; ++j) { const unsigned c = xb_ld(&bar[XB_XCNT(j)]); sum += c; cnt += (c > 0u) ? 1u : 0u; mine = (j == x) ? c : mine; }
        if (sum == G) break;
        __builtin_amdgcn_s_sleep(1);
        if ((++sp & 255u) == 0u) { if (xb_ld(&bar[XB_TMO])) break; if (sp > XB_SPIN_CAP) { atomicAdd(&bar[XB_TMO], 1u); break; } }
    }
    nloc = mine > 0u ? mine : 1u; nx = cnt > 0u ? cnt : 1u;
}
DI void grid_barrier(unsigned* bar, volatile unsigned* st) {
    asm volatile("s_waitcnt vmcnt(0)" ::: "memory");
    __syncthreads();
    if (threadIdx.x == 0) {
        const unsigned x = xb_xcc_id();
        __builtin_amdgcn_s_waitcnt(0);
        unsigned nloc = st[0], nx = st[1];
        if (nloc == 0u) { xcd_barrier_complete(bar, x, nloc, nx); st[0] = nloc; st[1] = nx; }
        const unsigned old = xb_add(&bar[XB_XSUB(x)], 1u);
        const unsigned gen = old / nloc;
        if (old + 1u == (gen + 1u) * nloc) {
            __builtin_amdgcn_fence(__ATOMIC_RELEASE, "agent");
            asm volatile("s_waitcnt vmcnt(0)" ::: "memory");
            const unsigned og = xb_add(&bar[XB_TOP], 1u);
            const unsigned tg = og / nx;
            if (og + 1u == (tg + 1u) * nx) xb_add(&bar[XB_TOPGEN], 1u);
            else XB_SPIN(xb_ld(&bar[XB_TOPGEN]) == tg, bar);
            __builtin_amdgcn_fence(__ATOMIC_ACQUIRE, "agent");
            xb_add(&bar[XB_XGEN(x)], 1u);
            asm volatile("s_waitcnt vmcnt(0)" ::: "memory");
        } else {
            XB_SPIN(xb_ld(&bar[XB_XGEN(x)]) == gen, bar);
            __builtin_amdgcn_fence(__ATOMIC_ACQUIRE, "agent");
            asm volatile("s_waitcnt vmcnt(0)" ::: "memory");
        }
    }
    __syncthreads();
}

#ifdef NO_S5
#define S5P1(...)
#define S5P3(...)
#else
#define S5P1(...) s5_pass1(__VA_ARGS__)
#define S5P3(...) s5_pass3(__VA_ARGS__)
#endif
#ifdef NO_ATT0
#define ATT0(...)
#else
#define ATT0(...) attn_item<0, 128>(__VA_ARGS__)
#endif
#ifdef NO_ATT1
#define ATT1(...)
#else
#define ATT1(...) attn_item<1, 64>(__VA_ARGS__)
#endif
#ifdef NO_ATT2
#define ATT2(...)
#else
#define ATT2(...) attn_item<2, 128>(__VA_ARGS__)
#endif
#ifdef NO_GEMM
#define GEMM(...)
#else
#define GEMM(...) pg8::gemm_phase<__VA_ARGS__
#endif
DI int next_item_xcd(unsigned* ctrs, int nper, unsigned char* lds) {
    volatile int* si = (volatile int*)(lds + LDS_MISC);
    __syncthreads();
    if (threadIdx.x == 0) {
        const unsigned x0 = xb_xcc_id() & 7u; int res = -1;
        for (unsigned k = 0; k < 8u; ++k) { const unsigned q = (x0 + k) & 7u; if (xb_ld(&ctrs[q]) >= (unsigned)nper) continue; const unsigned v = xb_add(&ctrs[q], 1u); if (v < (unsigned)nper) { res = (int)(q * (unsigned)nper + v); break; } }
        *si = res;
    }
    __syncthreads();
    return *si;
}
__global__ void __launch_bounds__(512, 2) fwd_kernel(Params karg) {
    extern __shared__ __attribute__((aligned(16))) unsigned char lds[];
    cg::grid_group grid = cg::this_grid();
    {
        volatile unsigned* st = (volatile unsigned*)(lds + LDS_MISC + 16);
        if (threadIdx.x == 0) { st[0] = 0u; st[1] = 0u; }
        __syncthreads();
        KPtr p0 = launder_kp();
        if (p0->ws == nullptr) grid.sync();
        if (threadIdx.x == 0) (void)xb_add(&((unsigned*)(p0->ws + OFF_BAR))[XB_XCNT(xb_xcc_id())], 1u);
    }
#define GBAR() do { KPtr pb_ = launder_kp(); grid_barrier((unsigned*)(pb_->ws + OFF_BAR), (volatile unsigned*)(lds + LDS_MISC + 16)); } while (0)
#define PH_VARS KPtr p = launder_kp(); PG8_LAS unsigned char* l3 = (PG8_LAS unsigned char*)lds; const int G = osgpr(gridDim.x), c = osgpr(blockIdx.x); unsigned char* ws = p->ws; const char* xb = (const char*)(ws + OFF_XB); float* ssq = (float*)(ws + OFF_SSQ); unsigned* ctr = (unsigned*)(ws + OFF_SCAL) + 8; (void)l3; (void)G; (void)c; (void)xb; (void)ssq; (void)ctr;
    {
        PH_VARS
#ifndef NO_PREP
        phase_prep(p, lds);
#endif
    }
    GBAR();
    for (int f = 0; f < 4; ++f) {
        {
            PH_VARS
            pg8::Sched2 S{64, 22, 1408, 0, 0, 0, G, c, xb, (const char*)(ws + (size_t)f * SZ_FFN), nullptr, nullptr};
            EpiGateUp E{ssq, (bf16_t*)(ws + OFF_HID)}; rstd_cache_reset();
#if !defined(ONLY_G) || ONLY_G == 0
            pg8::gemm_phase<EpiGateUp, pg8::Sched2>(l3, 1024, S, E, nullptr);
#endif
        }
        GBAR();
        {
            PH_VARS
            pg8::Sched2 S{64, 4, 256, 0, 0, 0, G, c, (const char*)(ws + OFF_HID), (const char*)(ws + (size_t)f * SZ_FFN + SZ_WGU), nullptr, nullptr};
            EpiResid E{f == 0 ? p->in[0] : (const float*)nullptr, (bf16_t*)(ws + OFF_XB), ssq, 0.5f};
#if !defined(ONLY_G) || ONLY_G == 1
            pg8::gemm_phase<EpiResid, pg8::Sched2>(l3, FFH, S, E, nullptr);
#endif
        }
        GBAR();
        if (f == 0) {
            {
                PH_VARS
                pg8::Sched2 S{64, 6, 384, 2, 64, 128, G, c, xb, (const char*)(ws + OFF_WIN0), (const char*)(ws + OFF_WIN0 + (size_t)1536 * 1024 * 2), xb};
                EpiWin0 E{ssq, (bf16_t*)(ws + OFF_P0), (bf16_t*)(ws + OFF_VT0), (const f32x2*)(ws + OFF_ROPE)}; rstd_cache_reset();
#if !defined(ONLY_G) || ONLY_G == 2
                pg8::gemm_phase<EpiWin0, pg8::Sched2>(l3, 1024, S, E, nullptr);
#endif
            }
            GBAR();
            {
                PH_VARS
                for (;;) {
                    const int it = next_item_xcd(ctr + 0, 128, lds); if (it < 0) break;
                    const int x = it >> 7, j = it & 127;
                    const int s5lo = osgpr(0);
                    if (j >= s5lo && j < s5lo + 64) { S5P1(p, lds, x * 64 + (j - s5lo)); }
                    else { const int idx = j < s5lo ? j : j - 64; const int qblk = 31 - (idx >> 1), bh = 2 * x + (idx & 1); ATT0(p, lds, bh >> 2, bh & 3, qblk); }
                }
            }
            GBAR();
            {
                PH_VARS
                for (int it = c; it < 512; it += G) { S5P3(p, lds, it); }
            }
            GBAR();
            {
                PH_VARS
                pg8::Sched2 S{64, 2, 128, 0, 0, 0, G, c, (const char*)(ws + OFF_Z), (const char*)(ws + OFF_WGLU), nullptr, nullptr};
                EpiGLU E{(const bf16_t*)(ws + OFF_Z), p->in[21], (bf16_t*)(ws + OFF_YC0)};
#if !defined(ONLY_G) || ONLY_G == 3
                pg8::gemm_phase<EpiGLU, pg8::Sched2>(l3, 512, S, E, nullptr);
#endif
            }
            GBAR();
        }
        if (f == 2) {
            {
                PH_VARS
                pg8::Sched2 S{64, 8, 512, 4, 64, 256, G, c, xb, (const char*)(ws + OFF_WIN1), (const char*)(ws + OFF_WIN1 + (size_t)2304 * 1024 * 2), xb};
                EpiWin1 E{ssq, (bf16_t*)(ws + OFF_P1), (bf16_t*)(ws + OFF_VT1), (float*)(ws + OFF_GATES)}; rstd_cache_reset();
#if !defined(ONLY_G) || ONLY_G == 4
                pg8::gemm_phase<EpiWin1, pg8::Sched2>(l3, 1024, S, E, nullptr);
#endif
                gates_job(p);
            }
            GBAR();
            {
                PH_VARS
#ifndef NO_L1PREP
                phase_l1prep(p, lds);
#endif
            }
            GBAR();
            {
                PH_VARS
                for (;;) {
                    const int it = next_item_xcd(ctr + 8, 80, lds); if (it < 0) break;
                    const int x = it / 80, j = it % 80;
                    if (j < 16) { mlstm_local(p, lds, x * 16 + j); }
                    else { const int jj = j - 16, qblk = 15 - jj / 4, bh = 4 * x + (jj & 3); ATT1(p, lds, bh >> 3, bh & 7, qblk); }
                }
            }
            GBAR();
            {
                PH_VARS
                mlstm_prefix(p);
            }
            GBAR();
            {
                PH_VARS
                for (int it = c; it < 256; it += G) { const int bh = it & 15, qblk = it >> 4; attn_item<2, 128, true>(p, lds, bh >> 2, bh & 3, qblk); __syncthreads(); }
            }
            GBAR();
        }
        if (f == 0 || f == 2) {
            PH_VARS
            pg8::Sched2 S{64, 4, 256, 0, 0, 0, G, c, (const char*)(ws + (f == 0 ? OFF_YC0 : OFF_YC1)), (const char*)(ws + (f == 0 ? OFF_WOUT0 : OFF_WOUT1)), nullptr, nullptr};
            EpiResid E{(const float*)nullptr, (bf16_t*)(ws + OFF_XB), ssq, 1.0f};
#if !defined(ONLY_G) || ONLY_G == 5
            pg8::gemm_phase<EpiResid, pg8::Sched2>(l3, 1024, S, E, nullptr);
#endif
        }
        if (f == 0 || f == 2) GBAR();
    }
    {
        PH_VARS
        phase_final(p);
    }
}

extern "C" void kernel_launch(void* const* d_in, const int* in_sizes, int n_in, void* d_out, int out_size, void* d_ws, size_t ws_size, hipStream_t stream) {
    static int grid_blocks = 0;
    if (!grid_blocks) {
        int dev = 0, cus = 0, per_cu = 0;
        (void)hipGetDevice(&dev);
        (void)hipDeviceGetAttribute(&cus, hipDeviceAttributeMultiprocessorCount, dev);
        (void)hipFuncSetAttribute((const void*)fwd_kernel, hipFuncAttributeMaxDynamicSharedMemorySize, LDS_BYTES);
        (void)hipOccupancyMaxActiveBlocksPerMultiprocessor(&per_cu, (const void*)fwd_kernel, 512, LDS_BYTES);
        if (per_cu < 1) per_cu = 1;
        grid_blocks = cus * per_cu;
        if (n_in != 45 || ws_size < WS_END) fprintf(stderr, "kernel_launch: unexpected n_in %d / ws %zu\n", n_in, ws_size);
    }
    Params p{};
    for (int i = 0; i < 45; ++i) p.in[i] = (const float*)d_in[i];
    p.out = (float*)d_out; p.ws = (unsigned char*)d_ws;
    for (int i = 0; i < 8; ++i) p.inv_freq[i] = (float)pow(500000.0, -(double)(2 * i) / 16.0);
    (void)hipMemsetAsync((unsigned char*)d_ws + OFF_BAR, 0, BAR_BYTES, stream);
    void* args[] = {&p};
    hipError_t e = hipLaunchCooperativeKernel((const void*)fwd_kernel, dim3(grid_blocks), dim3(512), args, LDS_BYTES, stream);
    if (e != hipSuccess) fprintf(stderr, "cooperative launch failed: %s (grid %d)\n", hipGetErrorString(e), grid_blocks);
}
```

```cpp
#include <hip/hip_runtime.h>
#include <hip/hip_cooperative_groups.h>
#include <cstdio>
#include <cmath>
namespace cg = cooperative_groups;

#define PG8_LAS __attribute__((address_space(3)))
#define DI __device__ __forceinline__
typedef unsigned short bf16_t;
typedef short bf16x8 __attribute__((ext_vector_type(8)));
typedef float f32x4 __attribute__((ext_vector_type(4)));
typedef float f32x2 __attribute__((ext_vector_type(2)));
typedef float f32x16 __attribute__((ext_vector_type(16)));
typedef unsigned u32x4 __attribute__((ext_vector_type(4)));
typedef unsigned u32x2 __attribute__((ext_vector_type(2)));
typedef __bf16 bf16x2n __attribute__((ext_vector_type(2)));

constexpr int MT = 16384, DM = 1024, SEQ = 4096, FFH = 2816;
constexpr float LOG2E = 1.4426950408889634f;
constexpr float NEPS = 1e-6f;

constexpr size_t SZ_WGU = (size_t)5632 * 1024 * 2, SZ_WD = (size_t)1024 * 2816 * 2, SZ_FFN = SZ_WGU + SZ_WD;
constexpr size_t OFF_WIN0 = 4 * SZ_FFN;
constexpr size_t OFF_WGLU = OFF_WIN0 + (size_t)2048 * 1024 * 2;
constexpr size_t OFF_WOUT0 = OFF_WGLU + (size_t)512 * 512 * 2;
constexpr size_t OFF_WIN1 = OFF_WOUT0 + (size_t)1024 * 1024 * 2;
constexpr size_t OFF_WOUT1 = OFF_WIN1 + (size_t)3328 * 1024 * 2;
constexpr size_t OFF_XB = OFF_WOUT1 + (size_t)1024 * 1024 * 2;
constexpr size_t OFF_SSQ = OFF_XB + (size_t)MT * 1024 * 2;
constexpr size_t OFF_ROPE = OFF_SSQ + (size_t)16 * MT * 4;
constexpr size_t OFF_GATES = OFF_ROPE + (size_t)4096 * 8 * 8;
constexpr size_t OFF_MA = OFF_GATES + (size_t)MT * 16 * 4;
constexpr size_t OFF_MM = OFF_MA + (size_t)16 * 4096 * 4;
constexpr size_t OFF_MTT = OFF_MM + (size_t)16 * 4096 * 4;
constexpr size_t OFF_FF = OFF_MTT + (size_t)16 * 4096 * 4;
constexpr size_t OFF_S5E = OFF_FF + (size_t)32 * 4096 * 4;
constexpr size_t OFF_SCAL = OFF_S5E + (size_t)128 * 32 * 64 * 8;
constexpr size_t OFF_BAR = OFF_SCAL + 256;
constexpr size_t BAR_BYTES = 16384;
constexpr size_t OFF_U = OFF_BAR + BAR_BYTES;
constexpr size_t OFF_HID = OFF_U;
constexpr size_t OFF_P0 = OFF_U, OFF_VT0 = OFF_P0 + (size_t)MT * 1536 * 2, OFF_YC0 = OFF_VT0 + (size_t)512 * MT * 2, OFF_Z = OFF_YC0 + (size_t)MT * 1024 * 2;
constexpr size_t OFF_P1 = OFF_U, OFF_VT1 = OFF_P1 + (size_t)MT * 2048 * 2, OFF_YC1 = OFF_VT1 + (size_t)1024 * MT * 2;
constexpr size_t WS_END = OFF_YC1 + (size_t)MT * 1024 * 2;
static_assert(WS_END <= (size_t)256 * 1024 * 1024, "workspace");
static_assert(OFF_Z + (size_t)MT * 512 * 2 <= WS_END, "workspace L0");

constexpr int LDS_BYTES = 131072 + 1024 + 4352;
constexpr int LDS_RSTD = 131072 + 1024;
constexpr int LDS_MISC = 131072;

struct Params { const float* in[45]; float* out; unsigned char* ws; float inv_freq[8]; };
typedef const __attribute__((address_space(4))) Params* KPtr;
DI int otid() { int t = threadIdx.x; asm volatile("" : "+v"(t)); return t; }
DI int osgpr(int v) { asm volatile("" : "+s"(v)); return v; }
DI KPtr launder_kp() { KPtr q = (KPtr)__builtin_amdgcn_kernarg_segment_ptr(); asm volatile("" : "+s"(q)); return q; }

DI bf16_t f2bf(float f) { unsigned u = __float_as_uint(f); u += 0x7fffu + ((u >> 16) & 1u); return (bf16_t)(u >> 16); }
DI float bf2f(bf16_t b) { return __uint_as_float(((unsigned)b) << 16); }
DI unsigned pack2(float a, float b) { f32x2 v = {a, b}; bf16x2n r = __builtin_convertvector(v, bf16x2n); return __builtin_bit_cast(unsigned, r); }
DI float bflo(unsigned w) { return __uint_as_float(w << 16); }
DI float bfhi(unsigned w) { return __uint_as_float(w & 0xffff0000u); }
DI float fast_rcp(float x) { return __builtin_amdgcn_rcpf(x); }
DI float fast_exp2(float x) { return __builtin_amdgcn_exp2f(x); }
DI float sigmoidf_(float x) { return fast_rcp(1.0f + __expf(-x)); }

namespace pg8 {
constexpr int BM = 256, BK = 64, HALF = 128, HTB = HALF * BK * 2, STAGE_BYTES = 8 * HTB, NXCD = 8, WGM = 8;
__host__ __device__ __forceinline__ int lds_byte(int r, int c) { const int st = (r >> 4) * 2 + (c >> 5), rr = r & 15, cc = c & 31, ob = rr * 64 + cc * 2; return st * 1024 + (ob ^ (((ob >> 9) & 1) << 5)); }
__host__ __device__ __forceinline__ void stage_rc(int b, int& R, int& C) { const int st = b / 1024, sb = b % 1024, swz = sb ^ (((sb >> 9) & 1) << 5); R = (st >> 1) * 16 + swz / 64; C = (st & 1) * 32 + (swz % 64) / 2; }
__host__ __device__ __forceinline__ int perm32(int rho) { const int n = rho >> 4, i = rho & 15; return 8 * (i >> 2) + 4 * n + (i & 3); }
struct Unit { int pm, pn, kind; };
DI void decode_unit(int L, int nM, int nN, int& pm, int& pn) {
    const int nwg = nM * nN; int wgid = L; { const int q = nwg / NXCD, r = nwg % NXCD, xcd = wgid % NXCD, off = wgid / NXCD; wgid = (xcd < r ? xcd * (q + 1) : r * (q + 1) + (xcd - r) * q) + off; }
    const int nig = WGM * nN, gid = wgid / nig, fm = gid * WGM, gsz = (nM - fm) < WGM ? (nM - fm) : WGM;
    pm = fm + ((wgid % nig) % gsz); pn = (wgid % nig) / gsz;
}
struct Sched2 {
    int n1M, n1N, n1, n2M, n2N, n2, G, c; const char *A1, *B1, *A2, *B2;
    DI bool next(int i, Unit& u) const {
        long L = (long)i * G + c;
        if (L < n1) { decode_unit((int)L, n1M, n1N, u.pm, u.pn); u.kind = 0; return true; }
        L -= n1;
        if (L < n2) { decode_unit((int)L, n2M, n2N, u.pm, u.pn); u.kind = 1; return true; }
        return false;
    }
    DI const char* aptr(const Unit& u, size_t tstep) const { return (u.kind ? A2 : A1) + (size_t)u.pm * tstep; }
    DI const char* bptr(const Unit& u, size_t tstep) const { return (u.kind ? B2 : B1) + (size_t)u.pn * tstep; }
    DI void a_ready(const Unit&) const {}
    DI void done(const Unit&) const {}
};
DI long long wall_clock64_() { return 0; }
#define wall_clock64 wall_clock64_
template <class Epi, class Sched, bool STAMP = false>
__device__ __forceinline__ void gemm_phase(PG8_LAS unsigned char* lds, const int Kdim, const Sched& S, const Epi& E, unsigned long long* stamps) {
    const int tid = otid(), wid = __builtin_amdgcn_readfirstlane(tid >> 6), lane = tid & 63, wr = wid >> 2, wc = wid & 3, fr = lane & 15, fq = lane >> 4;
    const int K = Kdim, nt = K / BK;
    int ts_lo = 0, ts_hi = 0, nts = 0; const unsigned long long rt_entry = STAMP ? (unsigned long long)wall_clock64() : 0ull;
#define PG8_STAMP() do { if (STAMP && wid == 0 && nts < 64) { const unsigned long long _c = (unsigned long long)clock64(); \
        ts_lo = (lane == nts) ? (int)(unsigned)_c : ts_lo; ts_hi = (lane == nts) ? (int)(unsigned)(_c >> 32) : ts_hi; ++nts; } } while (0)
    PG8_STAMP();
    unsigned voffA[2], voffB[2];
#pragma unroll
    for (int i = 0; i < 2; ++i) { int R, C; stage_rc(tid * 16 + i * 8192, R, C); const int Rb = Epi::PERM ? ((R & ~31) + perm32(R & 31)) : R;
        voffA[i] = (unsigned)(R * K + C) * 2u; voffB[i] = (unsigned)(Rb * K + C) * 2u; }
    const size_t kstep = (size_t)(BK * 2);
    const size_t hstep = (size_t)HALF * K * 2;
    const size_t tstep = 2 * hstep;
    const unsigned ldsw = (unsigned)wid * 1024u;
    const int aoff = lds_byte(wr * 64 + fr, fq * 8), boff = lds_byte(wc * 32 + fr, fq * 8);
#define PG8_SA(b, h) (((b) * 2 + (h)) * HTB)
#define PG8_SB(b, h) ((4 + (b) * 2 + (h)) * HTB)
#define PG8_STAGE(bufoff, gbase, voff) do { _Pragma("unroll") for (int _i = 0; _i < 2; ++_i) \
        __builtin_amdgcn_global_load_lds((const unsigned*)((const char*)(gbase) + (voff)[_i]), (PG8_LAS unsigned*)(lds + (bufoff) + ldsw + _i * 8192), 16, 0, 0); } while (0)
#define PG8_LDA(dst, b, h) do { _Pragma("unroll") for (int m = 0; m < 4; ++m) _Pragma("unroll") for (int k = 0; k < 2; ++k) dst[m][k] = *(const PG8_LAS bf16x8*)(lds + PG8_SA(b, h) + aoff + m * 2048 + k * 1024); } while (0)
#define PG8_LDB(dst, b, h) do { _Pragma("unroll") for (int n = 0; n < 2; ++n) _Pragma("unroll") for (int k = 0; k < 2; ++k) dst[n][k] = *(const PG8_LAS bf16x8*)(lds + PG8_SB(b, h) + boff + n * 2048 + k * 1024); } while (0)
#define PG8_MMA(ai, bj, At, Bt) do { __builtin_amdgcn_s_setprio(1); _Pragma("unroll") for (int m = 0; m < 4; ++m) _Pragma("unroll") for (int n = 0; n < 2; ++n) _Pragma("unroll") for (int k = 0; k < 2; ++k) \
        acc[ai][bj][m][n] = __builtin_amdgcn_mfma_f32_16x16x32_bf16(Bt[n][k], At[m][k], acc[ai][bj][m][n], 0, 0, 0); __builtin_amdgcn_s_setprio(0); } while (0)
#define PG8_WAIT_V(n) asm volatile("s_waitcnt vmcnt(" #n ")" ::: "memory")
#define PG8_WAIT_L(n) asm volatile("s_waitcnt lgkmcnt(" #n ")" ::: "memory")
#define PG8_BAR __builtin_amdgcn_s_barrier()
#define PG8_SCHED __builtin_amdgcn_sched_barrier(0)
    Unit cur, nxt; int ui = 0;
    if (!S.next(0, cur)) return;
    f32x4 acc[2][2][4][2];
#pragma unroll
    for (int a = 0; a < 2; ++a)
#pragma unroll
        for (int b = 0; b < 2; ++b)
#pragma unroll
            for (int m = 0; m < 4; ++m)
#pragma unroll
                for (int n = 0; n < 2; ++n) acc[a][b][m][n] = (f32x4){0.f, 0.f, 0.f, 0.f};
    bf16x8 At[4][2], B0[2][2], B1[2][2];
    const char* cA = S.aptr(cur, tstep); const char* cB = S.bptr(cur, tstep);
    S.a_ready(cur);
    PG8_STAGE(PG8_SB(0, 0), cB, voffB); PG8_STAGE(PG8_SA(0, 0), cA, voffA); PG8_STAGE(PG8_SB(0, 1), cB + hstep, voffB); PG8_STAGE(PG8_SA(0, 1), cA + hstep, voffA);
    if (wr == 1) PG8_BAR;
    PG8_WAIT_V(4); PG8_BAR;
    PG8_STAGE(PG8_SB(1, 0), cB + kstep, voffB); PG8_STAGE(PG8_SA(1, 0), cA + kstep, voffA); PG8_STAGE(PG8_SB(1, 1), cB + hstep + kstep, voffB);
    PG8_WAIT_V(6); PG8_BAR;
    PG8_STAMP();
    for (;;) {
        const bool has_next = S.next(ui + 1, nxt);
        const char* nA = has_next ? S.aptr(nxt, tstep) : cA; const char* nB = has_next ? S.bptr(nxt, tstep) : cB;
        for (int t = 0; t < nt; t += 2) {
            const bool last = (t == nt - 2);
            const char* a1 = cA + (size_t)(t + 1) * kstep;
            const char* a2 = last ? nA : cA + (size_t)(t + 2) * kstep; const char* b2 = last ? nB : cB + (size_t)(t + 2) * kstep;
            const char* a3 = a2 + kstep; const char* b3 = b2 + kstep;
            if (last && has_next) S.a_ready(nxt);
            PG8_LDB(B0, 0, 0); PG8_SCHED; PG8_LDA(At, 0, 0); PG8_STAGE(PG8_SA(1, 1), a1 + hstep, voffA);
            PG8_WAIT_L(8); PG8_BAR; PG8_WAIT_L(0); PG8_MMA(0, 0, At, B0); PG8_BAR; PG8_SCHED;
            PG8_LDB(B1, 0, 1); PG8_STAGE(PG8_SB(0, 0), b2, voffB);
            PG8_BAR; PG8_WAIT_L(0); PG8_MMA(0, 1, At, B1); PG8_BAR;
            PG8_LDA(At, 0, 1); PG8_STAGE(PG8_SA(0, 0), a2, voffA);
            PG8_BAR; PG8_WAIT_L(0); PG8_MMA(1, 0, At, B0); PG8_BAR; PG8_SCHED;
            PG8_STAGE(PG8_SB(0, 1), b2 + hstep, voffB);
            PG8_WAIT_V(6); PG8_BAR; PG8_MMA(1, 1, At, B1); PG8_BAR;
            PG8_LDB(B0, 1, 0); PG8_SCHED; PG8_LDA(At, 1, 0); PG8_STAGE(PG8_SA(0, 1), a2 + hstep, voffA);
            PG8_WAIT_L(8); PG8_BAR; PG8_WAIT_L(0); PG8_MMA(0, 0, At, B0); PG8_BAR; PG8_SCHED;
            PG8_LDB(B1, 1, 1); PG8_STAGE(PG8_SB(1, 0), b3, voffB);
            PG8_BAR; PG8_WAIT_L(0); PG8_MMA(0, 1, At, B1); PG8_BAR;
            PG8_LDA(At, 1, 1); PG8_STAGE(PG8_SA(1, 0), a3, voffA);
            PG8_BAR; PG8_WAIT_L(0); PG8_MMA(1, 0, At, B0); PG8_BAR; PG8_SCHED;
            PG8_STAGE(PG8_SB(1, 1), b3 + hstep, voffB);
            PG8_WAIT_V(6); PG8_BAR; PG8_MMA(1, 1, At, B1); PG8_BAR;
        }
        PG8_STAMP();
        if constexpr (!Epi::AFTER_DRAIN) { E(acc, cur, wr, wc, fr, fq); S.done(cur); }
        PG8_STAMP();
        if (!has_next) break;
#pragma unroll
        for (int a = 0; a < 2; ++a)
#pragma unroll
            for (int b = 0; b < 2; ++b)
#pragma unroll
                for (int m = 0; m < 4; ++m)
#pragma unroll
                    for (int n = 0; n < 2; ++n) acc[a][b][m][n] = (f32x4){0.f, 0.f, 0.f, 0.f};
        cur = nxt; cA = nA; cB = nB; ++ui;
    }
    PG8_WAIT_V(0);
    if (wr == 0) PG8_BAR;
    PG8_BAR;
    if constexpr (Epi::AFTER_DRAIN) { E.fused(acc, cur, wr, wc, fr, fq, lds, wid, lane); S.done(cur); }
    PG8_STAMP();
    if (STAMP && wid == 0) { stamps[lane] = lane < nts ? (((unsigned long long)(unsigned)ts_hi << 32) | (unsigned)ts_lo) : 0ull;
        if (lane == 62) stamps[62] = rt_entry; if (lane == 63) stamps[63] = (unsigned long long)wall_clock64(); }
#undef PG8_STAMP
#undef PG8_SA
#undef PG8_SB
#undef PG8_STAGE
#undef PG8_LDA
#undef PG8_LDB
#undef PG8_MMA
#undef PG8_WAIT_V
#undef PG8_WAIT_L
#undef PG8_BAR
#undef PG8_SCHED
}
#undef wall_clock64
}
using pg8::Unit;
typedef f32x4 AccT[2][2][4][2];

DI void row_rstd(const float* ssq, int row0, int fq, float (&rs)[2][4]) {
#pragma unroll
    for (int ai = 0; ai < 2; ++ai)
#pragma unroll
        for (int m = 0; m < 4; ++m) {
            const int row = row0 + ai * 128 + m * 16; float s = 0.f;
#pragma unroll
            for (int q = 0; q < 4; ++q) s += ssq[(size_t)(4 * fq + q) * MT + row];
            s += __shfl_xor(s, 16); s += __shfl_xor(s, 32);
            rs[ai][m] = rsqrtf(s * (1.0f / 1024.0f) + NEPS);
        }
}
DI void row_rstd_cached(const float* ssq, int tag, int row0, int wave, int fr, int fq, float (&rs)[2][4]) {
    PG8_LAS float* tab = (PG8_LAS float*)(unsigned)(LDS_RSTD + wave * 544); volatile PG8_LAS int* tagp = (volatile PG8_LAS int*)(unsigned)(LDS_RSTD + wave * 544 + 512);
    if (*tagp != tag) {
#pragma unroll
        for (int ai = 0; ai < 2; ++ai)
#pragma unroll
            for (int m = 0; m < 4; ++m) {
                const int row = row0 + ai * 128 + m * 16; float sq = 0.f;
#pragma unroll
                for (int q = 0; q < 4; ++q) sq += ssq[(size_t)(4 * fq + q) * MT + row];
                sq += __shfl_xor(sq, 16); sq += __shfl_xor(sq, 32);
                if (fq == 0) tab[(ai * 4 + m) * 16 + fr] = rsqrtf(sq * (1.0f / 1024.0f) + NEPS);
            }
        if (fr == 0 && fq == 0) *tagp = tag;
        asm volatile("s_waitcnt lgkmcnt(0)" ::: "memory");
    }
#pragma unroll
    for (int ai = 0; ai < 2; ++ai)
#pragma unroll
        for (int m = 0; m < 4; ++m) rs[ai][m] = tab[(ai * 4 + m) * 16 + fr];
}
DI void rstd_cache_reset() { const int t = otid(); if ((t & 63) == 0) *(volatile PG8_LAS int*)(unsigned)(LDS_RSTD + (t >> 6) * 544 + 512) = -1; }
DI u32x4 pack8(const f32x4& a, const f32x4& b) { u32x4 w; w.x = pack2(a[0], a[1]); w.y = pack2(a[2], a[3]); w.z = pack2(b[0], b[1]); w.w = pack2(b[2], b[3]); return w; }
DI void epi_vt(const AccT& acc, const Unit& u, int wr, int wc, int fr, int fq, const float* ssq, bf16_t* vt) {
    const int tokb = u.pn * 256 + wc * 32 + 8 * fq;
    f32x4 rt[2][2];
#pragma unroll
    for (int bj = 0; bj < 2; ++bj)
#pragma unroll
        for (int n = 0; n < 2; ++n) {
            f32x4 s = *(const f32x4*)(ssq + (size_t)fr * MT + tokb + bj * 128 + n * 4);
#pragma unroll
            for (int off = 1; off < 16; off <<= 1) { s[0] += __shfl_xor(s[0], off); s[1] += __shfl_xor(s[1], off); s[2] += __shfl_xor(s[2], off); s[3] += __shfl_xor(s[3], off); }
#pragma unroll
            for (int j = 0; j < 4; ++j) s[j] = rsqrtf(s[j] * (1.0f / 1024.0f) + NEPS);
            rt[bj][n] = s;
        }
#pragma unroll
    for (int ai = 0; ai < 2; ++ai)
#pragma unroll
        for (int m = 0; m < 4; ++m) {
            const int row = u.pm * 256 + ai * 128 + wr * 64 + m * 16 + fr;
#pragma unroll
            for (int bj = 0; bj < 2; ++bj) {
                const f32x4 v0 = acc[ai][bj][m][0] * rt[bj][0], v1 = acc[ai][bj][m][1] * rt[bj][1];
                *(u32x4*)(vt + (size_t)row * MT + tokb + bj * 128) = pack8(v0, v1);
            }
        }
}

struct EpiGateUp {
    static constexpr bool PERM = true, AFTER_DRAIN = false;
    const float* ssq; bf16_t* hid;
    DI void operator()(const AccT& acc, const Unit& u, int wr, int wc, int fr, int fq) const {
        const int row0 = u.pm * 256 + wr * 64 + fr; float rs[2][4]; row_rstd_cached(ssq, u.pm, row0, wr * 4 + wc, fr, fq, rs);
        const int colh = u.pn * 128 + wc * 32 + 8 * fq;
#pragma unroll
        for (int ai = 0; ai < 2; ++ai)
#pragma unroll
            for (int m = 0; m < 4; ++m) {
                const float r = rs[ai][m]; f32x4 h0, h1;
#pragma unroll
                for (int j = 0; j < 4; ++j) {
                    const float g0 = acc[ai][0][m][0][j] * r, g1 = acc[ai][0][m][1][j] * r, u0 = acc[ai][1][m][0][j] * r, u1 = acc[ai][1][m][1][j] * r;
                    h0[j] = g0 * sigmoidf_(g0) * u0; h1[j] = g1 * sigmoidf_(g1) * u1;
                }
                *(u32x4*)(hid + (size_t)(row0 + ai * 128 + m * 16) * FFH + colh) = pack8(h0, h1);
            }
    }
};
struct EpiResid {
    static constexpr bool PERM = false, AFTER_DRAIN = false;
    const float* xin32; bf16_t* xb; float* ssq; float scale;
    DI void operator()(const AccT& acc, const Unit& u, int wr, int wc, int fr, int fq) const {
        const int row0 = u.pm * 256 + wr * 64 + fr, col0 = u.pn * 256 + wc * 32 + 4 * fq;
#pragma unroll
        for (int ai = 0; ai < 2; ++ai)
#pragma unroll
            for (int m = 0; m < 4; ++m) {
                const int row = row0 + ai * 128 + m * 16; float ss = 0.f;
#pragma unroll
                for (int bj = 0; bj < 2; ++bj)
#pragma unroll
                    for (int n = 0; n < 2; ++n) {
                        const size_t o = (size_t)row * DM + col0 + bj * 128 + n * 16;
                        f32x4 xr;
                        if (xin32) xr = *(const f32x4*)(xin32 + o);
                        else { const u32x2 w0 = *(const u32x2*)(xb + o); xr[0] = bflo(w0.x); xr[1] = bfhi(w0.x); xr[2] = bflo(w0.y); xr[3] = bfhi(w0.y); }
                        const f32x4 xn = xr + acc[ai][bj][m][n] * scale;
                        u32x2 w; w.x = pack2(xn[0], xn[1]); w.y = pack2(xn[2], xn[3]); *(u32x2*)(xb + o) = w;
                        ss += (xn[0] * xn[0] + xn[1] * xn[1]) + (xn[2] * xn[2] + xn[3] * xn[3]);
                    }
                ss += __shfl_xor(ss, 16); ss += __shfl_xor(ss, 32);
                if (fq == 0) ssq[(size_t)(4 * u.pn + wc) * MT + row] = ss;
            }
    }
};
struct EpiWin0 {
    static constexpr bool PERM = true, AFTER_DRAIN = false;
    const float* ssq; bf16_t* p0; bf16_t* vt; const f32x2* rope;
    DI void operator()(const AccT& acc, const Unit& u, int wr, int wc, int fr, int fq) const {
        if (u.kind) { epi_vt(acc, u, wr, wc, fr, fq, ssq, vt); return; }
        const int row0 = u.pm * 256 + wr * 64 + fr; float rs[2][4]; row_rstd_cached(ssq, u.pm, row0, wr * 4 + wc, fr, fq, rs);
        const bool rot = (u.pn < 4) && !(wc & 1) && (fq < 2);
#pragma unroll
        for (int ai = 0; ai < 2; ++ai)
#pragma unroll
            for (int m = 0; m < 4; ++m) {
                const int row = row0 + ai * 128 + m * 16; const float r = rs[ai][m]; const int pos = row & (SEQ - 1);
#pragma unroll
                for (int bj = 0; bj < 2; ++bj) {
                    f32x4 v0 = acc[ai][bj][m][0] * r, v1 = acc[ai][bj][m][1] * r;
                    if (rot) {
                        const f32x2* tb = rope + pos * 8 + 4 * fq;
#pragma unroll
                        for (int j = 0; j < 4; ++j) { const f32x2 cs = tb[j]; const float x1 = v0[j], x2 = v1[j]; v0[j] = x1 * cs.x - x2 * cs.y; v1[j] = x2 * cs.x + x1 * cs.y; }
                    }
                    *(u32x4*)(p0 + (size_t)row * 1536 + u.pn * 256 + bj * 128 + wc * 32 + 8 * fq) = pack8(v0, v1);
                }
            }
    }
};
struct EpiWin1 {
    static constexpr bool PERM = true, AFTER_DRAIN = false;
    const float* ssq; bf16_t* p1; bf16_t* vt; float* gates;
    DI void operator()(const AccT& acc, const Unit& u, int wr, int wc, int fr, int fq) const {
        if (u.kind) { epi_vt(acc, u, wr, wc, fr, fq, ssq, vt); return; }
        const int row0 = u.pm * 256 + wr * 64 + fr; float rs[2][4]; row_rstd_cached(ssq, u.pm, row0, wr * 4 + wc, fr, fq, rs);
#pragma unroll
        for (int ai = 0; ai < 2; ++ai)
#pragma unroll
            for (int m = 0; m < 4; ++m) {
                const int row = row0 + ai * 128 + m * 16; const float r = rs[ai][m];
                if (u.pn < 8) {
#pragma unroll
                    for (int bj = 0; bj < 2; ++bj) {
                        const f32x4 v0 = acc[ai][bj][m][0] * r, v1 = acc[ai][bj][m][1] * r;
                        *(u32x4*)(p1 + (size_t)row * 2048 + u.pn * 256 + bj * 128 + wc * 32 + 8 * fq) = pack8(v0, v1);
                    }
                } else if (wc == 0 && fq < 2) {
                    *(f32x4*)(gates + (size_t)row * 16 + 8 * fq) = acc[ai][0][m][0] * r;
                    *(f32x4*)(gates + (size_t)row * 16 + 8 * fq + 4) = acc[ai][0][m][1] * r;
                }
            }
    }
};
struct EpiGLU {
    static constexpr bool PERM = true, AFTER_DRAIN = false;
    const bf16_t* z; const float* bias; bf16_t* ycat;
    DI void operator()(const AccT& acc, const Unit& u, int wr, int wc, int fr, int fq) const {
        const int row0 = u.pm * 256 + wr * 64 + fr, colb = u.pn * 256 + wc * 32 + 8 * fq;
#pragma unroll
        for (int bj = 0; bj < 2; ++bj) {
            const int col = colb + bj * 128;
            const f32x4 b0 = *(const f32x4*)(bias + col), b1 = *(const f32x4*)(bias + col + 4);
#pragma unroll
            for (int ai = 0; ai < 2; ++ai)
#pragma unroll
                for (int m = 0; m < 4; ++m) {
                    const int row = row0 + ai * 128 + m * 16;
                    const u32x4 zz = *(const u32x4*)(z + (size_t)row * 512 + col);
                    const f32x4 g0 = acc[ai][bj][m][0] + b0, g1 = acc[ai][bj][m][1] + b1; f32x4 o0, o1;
                    o0[0] = bflo(zz.x) * sigmoidf_(g0[0]); o0[1] = bfhi(zz.x) * sigmoidf_(g0[1]); o0[2] = bflo(zz.y) * sigmoidf_(g0[2]); o0[3] = bfhi(zz.y) * sigmoidf_(g0[3]);
                    o1[0] = bflo(zz.z) * sigmoidf_(g1[0]); o1[1] = bfhi(zz.z) * sigmoidf_(g1[1]); o1[2] = bflo(zz.w) * sigmoidf_(g1[2]); o1[3] = bfhi(zz.w) * sigmoidf_(g1[3]);
                    *(u32x4*)(ycat + (size_t)row * 1024 + 512 + col) = pack8(o0, o1);
                }
        }
    }
};

struct Job { const float* W; const float* W2; const float* gain; bf16_t* dst; int K, ldw, nrows, kind; };
DI int ffn_base(int f) { return f == 0 ? 1 : (f == 1 ? 23 : (f == 2 ? 27 : 40)); }
DI Job get_job(KPtr p, int j) {
    Job J; J.W2 = nullptr; J.gain = nullptr; J.kind = 0;
    if (j < 4) { const int nb = ffn_base(j); J.W = p->in[nb + 1]; J.W2 = p->in[nb + 2]; J.gain = p->in[nb]; J.dst = (bf16_t*)(p->ws + (size_t)j * SZ_FFN); J.K = 1024; J.ldw = FFH; J.nrows = 5632; J.kind = 1; }
    else if (j < 8) { const int nb = ffn_base(j - 4); J.W = p->in[nb + 3]; J.dst = (bf16_t*)(p->ws + (size_t)(j - 4) * SZ_FFN + SZ_WGU); J.K = FFH; J.ldw = 1024; J.nrows = 1024; }
    else if (j == 8) { J.W = p->in[6]; J.gain = p->in[5]; J.dst = (bf16_t*)(p->ws + OFF_WIN0); J.K = 1024; J.ldw = 2048; J.nrows = 2048; J.kind = 2; }
    else if (j == 9) { J.W = p->in[20]; J.dst = (bf16_t*)(p->ws + OFF_WGLU); J.K = 512; J.ldw = 512; J.nrows = 512; }
    else if (j == 10) { J.W = p->in[22]; J.dst = (bf16_t*)(p->ws + OFF_WOUT0); J.K = 1024; J.ldw = 1024; J.nrows = 1024; }
    else if (j == 11) { J.W = p->in[32]; J.gain = p->in[31]; J.dst = (bf16_t*)(p->ws + OFF_WIN1); J.K = 1024; J.ldw = 3088; J.nrows = 3328; J.kind = 3; }
    else { J.W = p->in[39]; J.dst = (bf16_t*)(p->ws + OFF_WOUT1); J.K = 1024; J.ldw = 1024; J.nrows = 1024; }
    return J;
}
DI int job_tiles(int j) { return j < 4 ? 176 : (j < 8 ? 88 : (j == 8 ? 64 : (j == 9 ? 8 : (j == 11 ? 104 : 32)))); }
DI int map_col(int kind, int n, bool& w2) {
    w2 = false;
    if (kind == 0) return n;
    if (kind == 1) { w2 = (n >> 7) & 1; return (n >> 8) * 128 + (n & 127); }
    if (kind == 2) {
        if (n < 1024) { const int pos = n & 63, base = n - pos; int lg = pos; if (pos < 16) lg = pos < 8 ? (pos < 4 ? pos : pos + 4) : (pos < 12 ? pos - 4 : pos); return base + lg; }
        if (n < 1536) return 1536 + (n - 1024);
        return 1024 + (n - 1536);
    }
    if (n < 512) return n;
    if (n < 1024) return 1032 + (n - 512);
    if (n < 1536) return 1544 + (n - 1024);
    if (n < 2048) return 2056 + (n - 1536);
    if (n < 2304) { const int j = n - 2048; return j < 4 ? 1024 : (j < 8 ? 1028 : (j < 16 ? 3080 + (j - 8) : -1)); }
    if (n < 2816) return 512 + (n - 2304);
    return 2568 + (n - 2816);
}
DI void phase_prep(KPtr p, unsigned char* lds) {
    const int tid = otid(), lane = tid & 63, wid = tid >> 6;
    if (blockIdx.x == 0 && wid == 0) {
        float s1 = p->in[7][lane] * p->in[8][lane], s2 = p->in[9][lane] * p->in[10][lane];
#pragma unroll
        for (int off = 1; off < 64; off <<= 1) { s1 += __shfl_xor(s1, off); s2 += __shfl_xor(s2, off); }
        if (lane == 0) { float* sc = (float*)(p->ws + OFF_SCAL); sc[0] = expf(s1) - expf(s2) + 0.2f; }
        if (lane < 48) ((unsigned*)(p->ws + OFF_SCAL) + 8)[lane] = 0u;
    }
    for (int idx = blockIdx.x * 512 + tid; idx < 4096 * 8; idx += gridDim.x * 512) {
        const int pos = idx >> 3, i = idx & 7; float fi = p->inv_freq[0];
        fi = i == 1 ? p->inv_freq[1] : fi; fi = i == 2 ? p->inv_freq[2] : fi; fi = i == 3 ? p->inv_freq[3] : fi; fi = i == 4 ? p->inv_freq[4] : fi; fi = i == 5 ? p->inv_freq[5] : fi; fi = i == 6 ? p->inv_freq[6] : fi; fi = i == 7 ? p->inv_freq[7] : fi;
        const float angf = (float)pos * fi; const double a = (double)angf; const double kk = rint(a * 0.15915494309189535); const double r = a - kk * 6.283185307179586;
        const float fr = (float)(r * 0.15915494309189535);
        f32x2 cs; cs.x = __builtin_amdgcn_cosf(fr); cs.y = __builtin_amdgcn_sinf(fr);
        ((f32x2*)(p->ws + OFF_ROPE))[idx] = cs;
    }
    {
        const float* x = p->in[0]; bf16_t* xb = (bf16_t*)(p->ws + OFF_XB); float* ssq = (float*)(p->ws + OFF_SSQ);
        const int rstride = gridDim.x * 8;
        for (int row0 = blockIdx.x * 8 + wid; row0 < MT; row0 += 4 * rstride) {
            f32x4 v[4][4];
#pragma unroll
            for (int rr = 0; rr < 4; ++rr) { const int row = row0 + rr * rstride;
#pragma unroll
                for (int i = 0; i < 4; ++i) v[rr][i] = row < MT ? *(const f32x4*)(x + (size_t)row * DM + i * 256 + lane * 4) : (f32x4){0.f, 0.f, 0.f, 0.f}; }
#pragma unroll
            for (int rr = 0; rr < 4; ++rr) { const int row = row0 + rr * rstride; if (row >= MT) break;
                float ss = 0.f;
#pragma unroll
                for (int i = 0; i < 4; ++i) { const size_t o = (size_t)row * DM + i * 256 + lane * 4; const f32x4 q = v[rr][i];
                    u32x2 w; w.x = pack2(q[0], q[1]); w.y = pack2(q[2], q[3]); *(u32x2*)(xb + o) = w; ss += (q[0] * q[0] + q[1] * q[1]) + (q[2] * q[2] + q[3] * q[3]); }
#pragma unroll
                for (int off = 1; off < 64; off <<= 1) ss += __shfl_xor(ss, off);
                if (lane < 16) ssq[(size_t)lane * MT + row] = lane == 0 ? ss : 0.f;
            }
        }
    }
    bf16_t* T = (bf16_t*)lds;
    for (int t = blockIdx.x; t < 1296; t += gridDim.x) {
        int j = 0, tt = t; while (tt >= job_tiles(j)) { tt -= job_tiles(j); ++j; }
        const Job J = get_job(p, j); const int nkt = J.K >> 7; const int n0 = (tt / nkt) * 256, k0 = (tt % nkt) * 128;
        const int nq = tid & 63, kr = tid >> 6; bool w2; const int sc = map_col(J.kind, n0 + 4 * nq, w2); const float* Ws = w2 ? J.W2 : J.W;
        f32x4 v[16]; float gk[16];
#pragma unroll
        for (int i = 0; i < 16; ++i) { const int k = k0 + kr + 8 * i; v[i] = sc >= 0 ? *(const f32x4*)(Ws + (size_t)k * J.ldw + sc) : (f32x4){0.f, 0.f, 0.f, 0.f}; gk[i] = J.gain ? J.gain[k] : 1.0f; }
#pragma unroll
        for (int i = 0; i < 16; ++i) { const int kl = kr + 8 * i;
#pragma unroll
            for (int e = 0; e < 4; ++e) T[(4 * nq + e) * 130 + kl] = f2bf(v[i][e] * gk[i]); }
        __syncthreads();
        { const int n = tid >> 1, ks = tid & 1; const unsigned* src = (const unsigned*)(T + n * 130 + 64 * ks); bf16_t* d = J.dst + (size_t)(n0 + n) * J.K + k0 + 64 * ks;
#pragma unroll
          for (int q = 0; q < 8; ++q) { u32x4 w; w.x = src[4 * q]; w.y = src[4 * q + 1]; w.z = src[4 * q + 2]; w.w = src[4 * q + 3]; *(u32x4*)(d + 8 * q) = w; } }
        __syncthreads();
    }
}
#define MFMA32(a, b, c) __builtin_amdgcn_mfma_f32_32x32x16_bf16((a), (b), (c), 0, 0, 0)
#define MFMA16(a, b, c) __builtin_amdgcn_mfma_f32_16x16x32_bf16((a), (b), (c), 0, 0, 0)
constexpr int AT_GRP = 26880, AT_V = 9216, AT_S = 26624;
template <int MODE, int DV, bool CH = false>
DI void attn_item(KPtr p, unsigned char* ldsb, int b, int hp, int qblk) {
    constexpr int NDB = DV / 32;
    const int tid = otid(), lane = tid & 63, wid = tid >> 6, g = wid >> 2, w = wid & 3, r = lane & 31, h = lane >> 5, tg = tid & 255;
    constexpr bool SH = (MODE != 0);
    constexpr int NKC = SH ? 1 : 2, NVC = DV / 64, LSTR = SH ? 512 : 256;
    constexpr bool VFO = (MODE != 2);
    constexpr int BSTR = SH ? 2 * AT_GRP : 36864;
    const int tl = SH ? tid : tg;
    const int tok0 = b * SEQ, head = hp;
    const bf16_t *Qb, *Kb, *Vt; int ld; const float* ksc = nullptr;
    if (MODE == 0) { const bf16_t* P0 = (const bf16_t*)(p->ws + OFF_P0); Qb = P0 + hp * 128 + g * 64; Kb = P0 + 512 + hp * 128 + g * 64; ld = 1536; Vt = (const bf16_t*)(p->ws + OFF_VT0) + (size_t)(hp * 128) * MT; }
    else if (MODE == 1) { const bf16_t* P1 = (const bf16_t*)(p->ws + OFF_P1); Qb = P1 + 1024 + head * 64; Kb = P1 + 1536 + head * 64; ld = 2048; Vt = (const bf16_t*)(p->ws + OFF_VT1) + (size_t)(512 + head * 64) * MT; ksc = (const float*)(p->ws + OFF_FF) + (size_t)(b * 8 + head) * SEQ; }
    else { const bf16_t* QK = (const bf16_t*)p->out; Qb = QK + head * 64; Kb = QK + 256 + head * 64; ld = 512; Vt = (const bf16_t*)(p->ws + OFF_VT1) + (size_t)(head * 128) * MT; ksc = (const float*)(p->ws + OFF_MA) + (size_t)(b * 4 + head) * SEQ; }
    unsigned char* Kl = ldsb + (SH ? 0 : g * 9216); unsigned char* Vl = ldsb + (SH ? AT_V : 18432);
    const int qpos = SH ? 256 * qblk + 128 * g + 32 * w + r : 128 * qblk + 32 * w + r; const size_t tq = (size_t)tok0 + qpos;
    bf16x8 qf[4];
#pragma unroll
    for (int ks = 0; ks < 4; ++ks) qf[ks] = *(const bf16x8*)(Qb + tq * ld + 16 * ks + 8 * h);
    float Fref = 0.f, Mlq = 0.f, mtq = 0.f;
    if (MODE == 1) Fref = ksc[256 * qblk];
    if (MODE == 2) Mlq = ((const float*)(p->ws + OFF_MM))[(size_t)(b * 4 + head) * SEQ + qpos];
    f32x16 O[NDB];
#pragma unroll
    for (int d = 0; d < NDB; ++d)
#pragma unroll
        for (int i = 0; i < 16; ++i) O[d][i] = 0.f;
    float m_run = -1e30f, lsum = 0.f;
    const int nkt = SH ? 4 * (qblk + 1) : 2 * (qblk + 1), ktmax = SH ? 4 * qblk + 2 * g + (w >> 1) : 2 * qblk + (w >> 1), kdiag = SH ? 4 * qblk + 2 * g : 2 * qblk;
    u32x4 kreg[NKC], vreg[NVC]; float sreg = 0.f;
#define AT_LOAD(kt_) do { const size_t key0 = (size_t)tok0 + 64 * (kt_); \
        _Pragma("unroll") for (int i_ = 0; i_ < NKC; ++i_) { const int c_ = tl + LSTR * i_; kreg[i_] = *(const u32x4*)(Kb + (key0 + (c_ >> 3)) * ld + (c_ & 7) * 8); } \
        _Pragma("unroll") for (int i_ = 0; i_ < NVC; ++i_) { const int c_ = tid + 512 * i_; vreg[i_] = *(const u32x4*)(Vt + (size_t)(c_ >> 3) * MT + key0 + (c_ & 7) * 8); } \
        if (MODE != 0 && tl < 64) sreg = ksc[64 * (kt_) + tl]; } while (0)
#define AT_STORE(buf_) do { unsigned char* Kd_ = Kl + (buf_) * BSTR; unsigned char* Vd_ = Vl + (buf_) * BSTR; \
        _Pragma("unroll") for (int i_ = 0; i_ < NKC; ++i_) { const int c_ = tl + LSTR * i_; *(u32x4*)(Kd_ + (c_ >> 3) * 144 + (c_ & 7) * 16) = kreg[i_]; } \
        _Pragma("unroll") for (int i_ = 0; i_ < NVC; ++i_) { const int c_ = tid + 512 * i_; unsigned char* d_ = VFO ? Vd_ + (c_ >> 3) * 144 + ((c_ & 7) >> 1) * 32 + (c_ & 1) * 8 : Vd_ + (c_ >> 3) * 136 + (c_ & 7) * 16; u32x2 lo_, hi_; lo_.x = vreg[i_].x; lo_.y = vreg[i_].y; hi_.x = vreg[i_].z; hi_.y = vreg[i_].w; *(u32x2*)d_ = lo_; *(u32x2*)(d_ + (VFO ? 16 : 8)) = hi_; } \
        if (MODE != 0 && tl < 64) ((float*)(Kd_ + AT_S))[tl] = (MODE == 1) ? (Fref - sreg) * 8.0f : sreg; } while (0)
    const int kt0 = CH ? 4 * qblk : 0;
    AT_LOAD(kt0);
    AT_STORE(0);
    if (kt0 + 1 < nkt) AT_LOAD(kt0 + 1);
    __syncthreads();
    for (int kt = kt0; kt < nkt; ++kt) {
        const int cur = (kt - kt0) & 1;
        if (kt + 1 < nkt) AT_STORE(cur ^ 1);
        if (kt + 2 < nkt) AT_LOAD(kt + 2);
        unsigned char* const Kc = Kl + cur * BSTR; unsigned char* const Vc = Vl + cur * BSTR; float* const Sc = (float*)(Kc + AT_S);
        if (CH ? (kt == ktmax) : (kt <= ktmax)) {
            const bool diag = kt >= kdiag;
            bf16x8 kf[2][4]; f32x4 sv[2][4];
#pragma unroll
            for (int kb = 0; kb < 2; ++kb)
#pragma unroll
                for (int ks = 0; ks < 4; ++ks) kf[kb][ks] = *(const bf16x8*)(Kc + (32 * kb + r) * 144 + 32 * ks + 16 * h);
            if (MODE != 0) {
#pragma unroll
                for (int kb = 0; kb < 2; ++kb)
#pragma unroll
                    for (int gq = 0; gq < 4; ++gq) sv[kb][gq] = *(const f32x4*)(Sc + 32 * kb + 8 * gq + 4 * h);
            }
            f32x16 sacc[2];
#pragma unroll
            for (int kb = 0; kb < 2; ++kb) {
                if (MODE == 1) {
#pragma unroll
                    for (int gq = 0; gq < 4; ++gq) { sacc[kb][4 * gq] = sv[kb][gq][0]; sacc[kb][4 * gq + 1] = sv[kb][gq][1]; sacc[kb][4 * gq + 2] = sv[kb][gq][2]; sacc[kb][4 * gq + 3] = sv[kb][gq][3]; }
                } else {
#pragma unroll
                    for (int i = 0; i < 16; ++i) sacc[kb][i] = 0.f;
                }
            }
#pragma unroll
            for (int ks = 0; ks < 4; ++ks)
#pragma unroll
                for (int kb = 0; kb < 2; ++kb) sacc[kb] = MFMA32(kf[kb][ks], qf[ks], sacc[kb]);
            u32x4 vf0[2][2][2];
#pragma unroll
            for (int d = 0; d < 2; ++d)
#pragma unroll
                for (int kb = 0; kb < 2; ++kb)
#pragma unroll
                    for (int s2 = 0; s2 < 2; ++s2) {
                        if (VFO) vf0[d][kb][s2] = *(const u32x4*)(Vc + (32 * d + r) * 144 + (32 * kb + 16 * s2) * 2 + 16 * h);
                        else { const unsigned char* va = Vc + (32 * d + r) * 136 + (32 * kb + 16 * s2 + 4 * h) * 2;
                        const u32x2 lo = *(const u32x2*)va, hi = *(const u32x2*)(va + 16); vf0[d][kb][s2].x = lo.x; vf0[d][kb][s2].y = lo.y; vf0[d][kb][s2].z = hi.x; vf0[d][kb][s2].w = hi.y; }
                    }
            if (MODE != 2) {
                const float c = 0.125f * LOG2E;
                if (diag) {
#pragma unroll
                    for (int kb = 0; kb < 2; ++kb)
#pragma unroll
                        for (int i = 0; i < 16; ++i) { const int key = 64 * kt + 32 * kb + (i & 3) + 8 * (i >> 2) + 4 * h; if (key > qpos) sacc[kb][i] = -1e30f; }
                }
                float mx = -1e30f;
#pragma unroll
                for (int kb = 0; kb < 2; ++kb)
#pragma unroll
                    for (int i = 0; i < 16; ++i) mx = fmaxf(mx, sacc[kb][i]);
                mx = fmaxf(mx, __shfl_xor(mx, 32));
                const float m_new = fmaxf(m_run, mx), alpha = fast_exp2((m_run - m_new) * c), mc = m_new * c;
                m_run = m_new; lsum *= alpha;
                if (__builtin_amdgcn_ballot_w64(alpha != 1.0f) != 0ull) {
#pragma unroll
                    for (int d = 0; d < NDB; ++d)
#pragma unroll
                        for (int i = 0; i < 16; ++i) O[d][i] *= alpha;
                }
#pragma unroll
                for (int kb = 0; kb < 2; ++kb)
#pragma unroll
                    for (int i = 0; i < 16; ++i) { const float pv = fast_exp2(sacc[kb][i] * c - mc); lsum += pv; sacc[kb][i] = pv; }
            } else {
#pragma unroll
                for (int kb = 0; kb < 2; ++kb)
#pragma unroll
                    for (int gq = 0; gq < 4; ++gq) {
#pragma unroll
                        for (int e = 0; e < 4; ++e) {
                            const int i = 4 * gq + e; float val = sacc[kb][i] * fast_exp2(sv[kb][gq][e] - Mlq);
                            if (diag) { const int key = 64 * kt + 32 * kb + 8 * gq + 4 * h + e; if (key > qpos) val = 0.f; }
                            lsum += val; sacc[kb][i] = val;
                        }
                    }
            }
            bf16x8 P[2][2];
#pragma unroll
            for (int kb = 0; kb < 2; ++kb)
#pragma unroll
                for (int s2 = 0; s2 < 2; ++s2) { u32x4 pk; pk.x = pack2(sacc[kb][8 * s2], sacc[kb][8 * s2 + 1]); pk.y = pack2(sacc[kb][8 * s2 + 2], sacc[kb][8 * s2 + 3]); pk.z = pack2(sacc[kb][8 * s2 + 4], sacc[kb][8 * s2 + 5]); pk.w = pack2(sacc[kb][8 * s2 + 6], sacc[kb][8 * s2 + 7]); P[kb][s2] = __builtin_bit_cast(bf16x8, pk); }
            u32x4 vf1[2][2][2];
            if (NDB == 4) {
#pragma unroll
                for (int d = 0; d < 2; ++d)
#pragma unroll
                    for (int kb = 0; kb < 2; ++kb)
#pragma unroll
                        for (int s2 = 0; s2 < 2; ++s2) {
                            if (VFO) vf1[d][kb][s2] = *(const u32x4*)(Vc + (32 * (d + 2) + r) * 144 + (32 * kb + 16 * s2) * 2 + 16 * h);
                            else { const unsigned char* va = Vc + (32 * (d + 2) + r) * 136 + (32 * kb + 16 * s2 + 4 * h) * 2;
                            const u32x2 lo = *(const u32x2*)va, hi = *(const u32x2*)(va + 16); vf1[d][kb][s2].x = lo.x; vf1[d][kb][s2].y = lo.y; vf1[d][kb][s2].z = hi.x; vf1[d][kb][s2].w = hi.y; }
                        }
            }
#pragma unroll
            for (int kb = 0; kb < 2; ++kb)
#pragma unroll
                for (int s2 = 0; s2 < 2; ++s2)
#pragma unroll
                    for (int d = 0; d < 2; ++d) O[d] = MFMA32(__builtin_bit_cast(bf16x8, vf0[d][kb][s2]), P[kb][s2], O[d]);
            if (NDB == 4) {
#pragma unroll
                for (int kb = 0; kb < 2; ++kb)
#pragma unroll
                    for (int s2 = 0; s2 < 2; ++s2)
#pragma unroll
                        for (int d = 0; d < 2; ++d) O[d + 2] = MFMA32(__builtin_bit_cast(bf16x8, vf1[d][kb][s2]), P[kb][s2], O[d + 2]);
            }
        }
        __syncthreads();
    }
#undef AT_STORE
#undef AT_LOAD
    if (CH && MODE == 2 && ktmax > 0) {
        const int bh = b * 4 + head; const bf16_t* LCp = (const bf16_t*)p->out + (size_t)8 * 1024 * 1024 + ((size_t)(bh * 64 + ktmax - 1) * 160) * 64;
        const float sc = fast_exp2(((const float*)(p->ws + OFF_MM))[(size_t)bh * SEQ + 64 * ktmax - 1] - Mlq);
#pragma unroll
        for (int db = 0; db < 5; ++db) {
            f32x16 I;
#pragma unroll
            for (int i = 0; i < 16; ++i) I[i] = 0.f;
#pragma unroll
            for (int ks = 0; ks < 4; ++ks) { const bf16x8 af = *(const bf16x8*)(LCp + (size_t)(32 * db + r) * 64 + 16 * ks + 8 * h); I = MFMA32(af, qf[ks], I); }
            if (db < 4) {
#pragma unroll
                for (int i = 0; i < 16; ++i) O[db < 4 ? db : 0][i] += I[i] * sc;
            } else if (h == 0) lsum += I[0] * sc;
        }
    }
    lsum += __shfl_xor(lsum, 32);
    if (MODE == 1) {
        const float inv = 1.0f / lsum; bf16_t* yc = (bf16_t*)(p->ws + OFF_YC1) + tq * 1024 + 512 + head * 64;
#pragma unroll
        for (int d = 0; d < NDB; ++d)
#pragma unroll
            for (int gq = 0; gq < 4; ++gq) { u32x2 wv; wv.x = pack2(O[d][4 * gq] * inv, O[d][4 * gq + 1] * inv); wv.y = pack2(O[d][4 * gq + 2] * inv, O[d][4 * gq + 3] * inv); *(u32x2*)(yc + 32 * d + 8 * gq + 4 * h) = wv; }
    } else if (MODE == 2) {
        mtq = ((const float*)(p->ws + OFF_MTT))[(size_t)(b * 4 + head) * SEQ + qpos];
        const float dd = fmaxf(fabsf(lsum), expf(-mtq)), inv = 1.0f / dd; float ss = 0.f;
#pragma unroll
        for (int d = 0; d < NDB; ++d)
#pragma unroll
            for (int i = 0; i < 16; ++i) { O[d][i] *= inv; ss += O[d][i] * O[d][i]; }
        ss += __shfl_xor(ss, 32);
        const float rstd = rsqrtf(ss * (1.0f / 128.0f) + NEPS);
        const bf16_t* og = (const bf16_t*)(p->ws + OFF_P1) + tq * 2048 + 512 + head * 128; const float* gn = p->in[37] + head * 128;
        bf16_t* yc = (bf16_t*)(p->ws + OFF_YC1) + tq * 1024 + head * 128;
#pragma unroll
        for (int d = 0; d < NDB; ++d)
#pragma unroll
            for (int gq = 0; gq < 4; ++gq) {
                const int dv = 32 * d + 8 * gq + 4 * h; const u32x2 ow = *(const u32x2*)(og + dv); const f32x4 gv = *(const f32x4*)(gn + dv);
                const float o0 = O[d][4 * gq] * rstd * gv[0] * sigmoidf_(bflo(ow.x)), o1 = O[d][4 * gq + 1] * rstd * gv[1] * sigmoidf_(bfhi(ow.x));
                const float o2 = O[d][4 * gq + 2] * rstd * gv[2] * sigmoidf_(bflo(ow.y)), o3 = O[d][4 * gq + 3] * rstd * gv[3] * sigmoidf_(bfhi(ow.y));
                u32x2 wv; wv.x = pack2(o0, o1); wv.y = pack2(o2, o3); *(u32x2*)(yc + dv) = wv;
            }
    } else {
        const float inv = 1.0f / lsum; float* X = (float*)ldsb;
        __syncthreads();
        if (g == 1) {
#pragma unroll
            for (int d = 0; d < NDB; ++d)
#pragma unroll
                for (int i = 0; i < 16; ++i) X[(32 * d + (i & 3) + 8 * (i >> 2) + 4 * h) * 128 + 32 * w + r] = O[d][i] * inv;
        }
        __syncthreads();
        if (g == 0) {
            const float lam = ((const float*)(p->ws + OFF_SCAL))[0]; float ss = 0.f;
#pragma unroll
            for (int d = 0; d < NDB; ++d)
#pragma unroll
                for (int i = 0; i < 16; ++i) { const float v = O[d][i] * inv - lam * X[(32 * d + (i & 3) + 8 * (i >> 2) + 4 * h) * 128 + 32 * w + r]; O[d][i] = v; ss += v * v; }
            ss += __shfl_xor(ss, 32);
            const float rstd = rsqrtf(ss * (1.0f / 128.0f) + NEPS) * 0.8f; const float* gn = p->in[11];
            bf16_t* yc = (bf16_t*)(p->ws + OFF_YC0) + tq * 1024 + hp * 128;
#pragma unroll
            for (int d = 0; d < NDB; ++d)
#pragma unroll
                for (int gq = 0; gq < 4; ++gq) {
                    const int dv = 32 * d + 8 * gq + 4 * h; const f32x4 gv = *(const f32x4*)(gn + dv);
                    u32x2 wv; wv.x = pack2(O[d][4 * gq] * rstd * gv[0], O[d][4 * gq + 1] * rstd * gv[1]); wv.y = pack2(O[d][4 * gq + 2] * rstd * gv[2], O[d][4 * gq + 3] * rstd * gv[3]); *(u32x2*)(yc + dv) = wv;
                }
        }
    }
}

DI void mlstm_local(KPtr p, unsigned char* lds, int item_) {
    const int tid_ = otid(); const int lane = tid_ & 63, wid = __builtin_amdgcn_readfirstlane(tid_ >> 6); const int item = __builtin_amdgcn_readfirstlane(item_);
    const int bh = item >> 3, c = (item & 7) * 8 + wid, b = bh >> 2, head = bh & 3, r = lane & 31, h = lane >> 5;
    const size_t tok0 = (size_t)b * SEQ + c * 64;
    const float* mA = (const float*)(p->ws + OFF_MA) + (size_t)bh * SEQ + c * 64; const float mend = ((const float*)(p->ws + OFF_MM))[(size_t)bh * SEQ + c * 64 + 63];
    const bf16_t* Kg = (const bf16_t*)p->out + tok0 * 512 + 256 + head * 64;
    unsigned char* Kl = lds + wid * 9216;
    __syncthreads();
#pragma unroll
    for (int i = 0; i < 8; ++i) {
        const int cc = lane + 64 * i, row = cc >> 3, part = cc & 7; const u32x4 kv = *(const u32x4*)(Kg + (size_t)row * 512 + part * 8); const float wgt = fast_exp2(mA[row] - mend);
        u32x4 o; o.x = pack2(bflo(kv.x) * wgt, bfhi(kv.x) * wgt); o.y = pack2(bflo(kv.y) * wgt, bfhi(kv.y) * wgt); o.z = pack2(bflo(kv.z) * wgt, bfhi(kv.z) * wgt); o.w = pack2(bflo(kv.w) * wgt, bfhi(kv.w) * wgt);
        *(u32x4*)(Kl + row * 144 + part * 16) = o;
    }
    asm volatile("s_waitcnt lgkmcnt(0)" ::: "memory");
    bf16x8 bfr[2][4];
#pragma unroll
    for (int nb = 0; nb < 2; ++nb)
#pragma unroll
        for (int ks = 0; ks < 4; ++ks)
#pragma unroll
            for (int j = 0; j < 8; ++j) bfr[nb][ks][j] = (short)*(const bf16_t*)(Kl + (16 * ks + 8 * h + j) * 144 + (32 * nb + r) * 2);
    const bf16_t* Vt = (const bf16_t*)(p->ws + OFF_VT1) + (size_t)(head * 128) * MT + tok0;
    bf16_t* LC = (bf16_t*)p->out + (size_t)8 * 1024 * 1024 + ((size_t)(bh * 64 + c) * 160) * 64;
#pragma unroll 1
    for (int db = 0; db < 5; ++db) {
        bf16x8 af[4];
        if (db < 4) {
#pragma unroll
            for (int ks = 0; ks < 4; ++ks) af[ks] = *(const bf16x8*)(Vt + (size_t)(32 * db + r) * MT + 16 * ks + 8 * h);
        } else {
            const short one = (r == 0) ? (short)0x3F80 : (short)0;
#pragma unroll
            for (int ks = 0; ks < 4; ++ks)
#pragma unroll
                for (int j = 0; j < 8; ++j) af[ks][j] = one;
        }
#pragma unroll
        for (int nb = 0; nb < 2; ++nb) {
            f32x16 acc;
#pragma unroll
            for (int i = 0; i < 16; ++i) acc[i] = 0.f;
#pragma unroll
            for (int ks = 0; ks < 4; ++ks) acc = MFMA32(af[ks], bfr[nb][ks], acc);
#pragma unroll
            for (int i = 0; i < 16; ++i) LC[(size_t)(32 * db + (i & 3) + 8 * (i >> 2) + 4 * h) * 64 + 32 * nb + r] = f2bf(acc[i]);
        }
    }
}
DI void mlstm_prefix(KPtr p) {
    const int tid = otid(); const float* mM = (const float*)(p->ws + OFF_MM);
    for (int idx = blockIdx.x * 512 + tid; idx < 16 * 5120; idx += gridDim.x * 512) {
        const int bh = idx / 5120, e = idx % 5120;
        unsigned* base = (unsigned*)((bf16_t*)p->out + (size_t)8 * 1024 * 1024) + (size_t)bh * 64 * 5120 + e;
        const float* mMb = mM + (size_t)bh * SEQ; float c0 = 0.f, c1 = 0.f;
#pragma unroll 1
        for (int hb = 0; hb < 4; ++hb) {
            unsigned wv[16]; float gd[16];
#pragma unroll
            for (int i = 0; i < 16; ++i) { const int c = hb * 16 + i; wv[i] = base[(size_t)c * 5120]; gd[i] = c == 0 ? 0.f : fast_exp2(mMb[64 * c - 1] - mMb[64 * c + 63]); }
#pragma unroll
            for (int i = 0; i < 16; ++i) { c0 = gd[i] * c0 + bflo(wv[i]); c1 = gd[i] * c1 + bfhi(wv[i]); wv[i] = pack2(c0, c1); }
#pragma unroll
            for (int i = 0; i < 16; ++i) base[(size_t)(hb * 16 + i) * 5120] = wv[i];
        }
    }
}

DI void s5_consts(KPtr p, int g, int lane, float& ar, float& ai, unsigned (&bbr)[8], unsigned (&bbi)[8]) {
    const float lr = p->in[12][g * 64 + lane], li = p->in[13][g * 64 + lane], dt = expf(p->in[14][g]);
    const float mag = expf(lr * dt); ar = mag * cosf(li * dt); ai = mag * sinf(li * dt);
    const float den = lr * lr + li * li, gr = ((ar - 1.0f) * lr + ai * li) / den, gi = (ai * lr - (ar - 1.0f) * li) / den;
    const f32x4* br4 = (const f32x4*)(p->in[15] + (size_t)(g * 64 + lane) * 16); const f32x4* bi4 = (const f32x4*)(p->in[16] + (size_t)(g * 64 + lane) * 16);
#pragma unroll
    for (int q = 0; q < 4; ++q) { const f32x4 br = br4[q], bi = bi4[q];
        bbr[2 * q] = pack2(gr * br[0] - gi * bi[0], gr * br[1] - gi * bi[1]); bbr[2 * q + 1] = pack2(gr * br[2] - gi * bi[2], gr * br[3] - gi * bi[3]);
        bbi[2 * q] = pack2(gr * bi[0] + gi * br[0], gr * bi[1] + gi * br[1]); bbi[2 * q + 1] = pack2(gr * bi[2] + gi * br[2], gr * bi[3] + gi * br[3]); }
}
constexpr int S5_X = 34816, S5_XW = 8448, S5_BT = 102400;
DI void s5_setup(KPtr p, unsigned char* lds, int g, int lane, float& ar, float& ai, bf16x8 (&bfr)[8]) {
    unsigned bbr[8], bbi[8]; s5_consts(p, g, lane, ar, ai, bbr, bbi);
    __syncthreads();
    u32x4* bt = (u32x4*)(lds + S5_BT); u32x4 w;
    w.x = bbr[0]; w.y = bbr[1]; w.z = bbr[2]; w.w = bbr[3]; bt[lane * 2] = w; w.x = bbr[4]; w.y = bbr[5]; w.z = bbr[6]; w.w = bbr[7]; bt[lane * 2 + 1] = w;
    w.x = bbi[0]; w.y = bbi[1]; w.z = bbi[2]; w.w = bbi[3]; bt[(64 + lane) * 2] = w; w.x = bbi[4]; w.y = bbi[5]; w.z = bbi[6]; w.w = bbi[7]; bt[(64 + lane) * 2 + 1] = w;
    __syncthreads();
    const int col = lane & 15, quad = lane >> 4;
#pragma unroll
    for (int nb = 0; nb < 8; ++nb) bfr[nb] = *(const bf16x8*)(lds + S5_BT + ((16 * nb + col) * 16 + 8 * (quad & 1)) * 2);
}
#define S5_XBLOCK(a_) do { const f32x4 z4_ = {0.f, 0.f, 0.f, 0.f}; \
        _Pragma("unroll") for (int nb_ = 0; nb_ < 8; ++nb_) { const f32x4 d_ = MFMA16((a_), bfr[nb_], z4_); \
            _Pragma("unroll") for (int j_ = 0; j_ < 4; ++j_) Xw[(4 * quad + j_) * 132 + 16 * nb_ + col] = d_[j_]; } \
        asm volatile("s_waitcnt lgkmcnt(0)" ::: "memory"); } while (0)
DI void s5_pass1(KPtr p, unsigned char* lds, int item_) {
    const int tid_ = otid(); const int lane = tid_ & 63, wid = __builtin_amdgcn_readfirstlane(tid_ >> 6); const int item = __builtin_amdgcn_readfirstlane(item_);
    const int bg = item >> 2, b = bg >> 5, g = bg & 31, c = (item & 3) * 8 + wid, col = lane & 15, quad = lane >> 4;
    float ar, ai; bf16x8 bfr[8]; s5_setup(p, lds, g, lane, ar, ai, bfr);
    float* Xw = (float*)(lds + S5_X + wid * S5_XW);
    const bf16_t* ub = (const bf16_t*)(p->ws + OFF_P0) + (size_t)(b * SEQ + c * 128 + col) * 1536 + 1024 + g * 16 + 8 * (quad & 1);
    const bf16x8 zero8 = {0, 0, 0, 0, 0, 0, 0, 0};
    float hr = 0.f, hi = 0.f;
    bf16x8 an = quad < 2 ? *(const bf16x8*)ub : zero8;
#pragma unroll 1
    for (int blk = 0; blk < 8; ++blk) {
        const bf16x8 a = an; if (blk < 7) an = quad < 2 ? *(const bf16x8*)(ub + (size_t)16 * (blk + 1) * 1536) : zero8;
        S5_XBLOCK(a);
#pragma unroll
        for (int tt = 0; tt < 16; ++tt) { const float xr = Xw[tt * 132 + lane], xi = Xw[tt * 132 + 64 + lane]; const float nr = ar * hr - ai * hi + xr, ni = ar * hi + ai * hr + xi; hr = nr; hi = ni; }
        asm volatile("s_waitcnt lgkmcnt(0)" ::: "memory");
    }
    f32x2 e; e.x = hr; e.y = hi; ((f32x2*)(p->ws + OFF_S5E))[((size_t)bg * 32 + c) * 64 + lane] = e;
}
DI void s5_pass3(KPtr p, unsigned char* lds, int item_) {
    const int tid_ = otid(); const int lane = tid_ & 63, wid = __builtin_amdgcn_readfirstlane(tid_ >> 6); const int item = __builtin_amdgcn_readfirstlane(item_);
    const int bg = item >> 2, b = bg >> 5, g = bg & 31, c = (item & 3) * 8 + wid, col = lane & 15, quad = lane >> 4;
    float ar, ai; bf16x8 bfr[8]; s5_setup(p, lds, g, lane, ar, ai, bfr);
    float pr = ar, pi = ai;
#pragma unroll
    for (int i = 0; i < 7; ++i) { const float t = pr * pr - pi * pi; pi = 2.0f * pr * pi; pr = t; }
    float hr = 0.f, hi = 0.f; const f32x2* E = (const f32x2*)(p->ws + OFF_S5E) + (size_t)bg * 32 * 64 + lane;
#pragma unroll 8
    for (int cc = 0; cc < 32; ++cc) {
        const bool on = cc < c; f32x2 e = {0.f, 0.f}; if (on) e = E[cc * 64];
        const float qr = on ? pr : 1.0f, qi = on ? pi : 0.0f;
        const float nr = qr * hr - qi * hi + e.x, ni = qr * hi + qi * hr + e.y; hr = nr; hi = ni;
    }
    const int hh = col;
    bf16x8 cb[4];
#pragma unroll
    for (int ks = 0; ks < 4; ++ks)
#pragma unroll
        for (int j = 0; j < 8; ++j) { const int k = 32 * ks + 8 * quad + j, sp = k >> 1; const float v = (k & 1) ? -p->in[18][(size_t)(g * 16 + hh) * 64 + sp] : p->in[17][(size_t)(g * 16 + hh) * 64 + sp]; cb[ks][j] = (short)f2bf(v); }
    const float dsk = p->in[19][g * 16 + hh];
    const bf16_t* P0 = (const bf16_t*)(p->ws + OFF_P0); bf16_t* Z = (bf16_t*)(p->ws + OFF_Z); const int tokb = b * SEQ + c * 128;
    bf16_t* Hs = (bf16_t*)(lds + wid * 4352);
    float* Xw = (float*)(lds + S5_X + wid * S5_XW);
    const bf16_t* ub = P0 + (size_t)(tokb + col) * 1536 + 1024 + g * 16 + 8 * (quad & 1);
    const bf16x8 zero8 = {0, 0, 0, 0, 0, 0, 0, 0};
    bf16x8 an = quad < 2 ? *(const bf16x8*)ub : zero8;
#pragma unroll 1
    for (int blk = 0; blk < 8; ++blk) {
        const bf16x8 a = an; if (blk < 7) an = quad < 2 ? *(const bf16x8*)(ub + (size_t)16 * (blk + 1) * 1536) : zero8;
        bf16_t uu4[4];
#pragma unroll
        for (int j = 0; j < 4; ++j) uu4[j] = P0[((size_t)tokb + blk * 16 + 4 * quad + j) * 1536 + 1024 + g * 16 + hh];
        S5_XBLOCK(a);
#pragma unroll
        for (int tt = 0; tt < 16; ++tt) {
            const float xr = Xw[tt * 132 + lane], xi = Xw[tt * 132 + 64 + lane]; const float nr = ar * hr - ai * hi + xr, ni = ar * hi + ai * hr + xi; hr = nr; hi = ni;
            *(unsigned*)(Hs + tt * 136 + 2 * lane) = pack2(hr, hi);
        }
        asm volatile("s_waitcnt lgkmcnt(0)" ::: "memory");
        f32x4 acc = {0.f, 0.f, 0.f, 0.f};
#pragma unroll
        for (int ks = 0; ks < 4; ++ks) { const bf16x8 af = *(const bf16x8*)(Hs + hh * 136 + 32 * ks + 8 * quad); acc = MFMA16(af, cb[ks], acc); }
        asm volatile("s_waitcnt lgkmcnt(0)" ::: "memory");
#pragma unroll
        for (int j = 0; j < 4; ++j) {
            const size_t tok = (size_t)tokb + blk * 16 + 4 * quad + j; const float uu = bf2f(uu4[j]);
            const float y = acc[j] + dsk * uu; const float zz = y * sigmoidf_(1.5957691216057308f * (y + 0.044715f * y * y * y));
            Z[tok * 512 + g * 16 + hh] = f2bf(zz);
        }
    }
}
#undef S5_XBLOCK

DI void gates_job(KPtr p) {
    const int tid = otid(), lane = tid & 63, wid = __builtin_amdgcn_readfirstlane(tid >> 6), r16 = lane & 15, quad = lane >> 4;
    const bf16_t* xb = (const bf16_t*)(p->ws + OFF_XB); const bf16_t* Wg = (const bf16_t*)(p->ws + OFF_WIN1) + (size_t)2048 * 1024;
    const float* ssq = (const float*)(p->ws + OFF_SSQ); float* gates = (float*)(p->ws + OFF_GATES);
    for (int tb = blockIdx.x * 8 + wid; tb < MT / 16; tb += gridDim.x * 8) {
        const int t0 = tb * 16;
        const bf16_t* ap = xb + (size_t)(t0 + r16) * 1024 + 8 * quad; const bf16_t* bp = Wg + (size_t)r16 * 1024 + 8 * quad;
        f32x4 acc = {0.f, 0.f, 0.f, 0.f};
#pragma unroll 1
        for (int k8 = 0; k8 < 4; ++k8) {
            bf16x8 a[8], b[8];
#pragma unroll
            for (int i = 0; i < 8; ++i) { a[i] = *(const bf16x8*)(ap + 32 * (8 * k8 + i)); b[i] = *(const bf16x8*)(bp + 32 * (8 * k8 + i)); }
#pragma unroll
            for (int i = 0; i < 8; ++i) acc = MFMA16(a[i], b[i], acc);
        }
        f32x4 sq = *(const f32x4*)(ssq + (size_t)r16 * MT + t0 + 4 * quad);
#pragma unroll
        for (int off = 1; off < 16; off <<= 1) { sq[0] += __shfl_xor(sq[0], off); sq[1] += __shfl_xor(sq[1], off); sq[2] += __shfl_xor(sq[2], off); sq[3] += __shfl_xor(sq[3], off); }
        { f32x4 gv;
#pragma unroll
          for (int j = 0; j < 4; ++j) gv[j] = acc[j] * rsqrtf(sq[j] * (1.0f / 1024.0f) + NEPS); *(f32x4*)(gates + (size_t)r16 * MT + t0 + 4 * quad) = gv; }
    }
}

DI float logsig(float x) { return fminf(x, 0.f) - log1pf(expf(-fabsf(x))); }
DI void phase_l1prep(KPtr p, unsigned char* lds) {
    const int tid = otid(), lane = tid & 63, wid = tid >> 6;
    const bf16_t* P1 = (const bf16_t*)(p->ws + OFF_P1); bf16_t* QK = (bf16_t*)p->out; const float* G = (const float*)(p->ws + OFF_GATES);
    const int nscan = gridDim.x > 96 ? 48 : 0;
    if ((int)blockIdx.x < 48) {
        const int task = blockIdx.x; const bool ml = task < 16; const int t2 = ml ? task : task - 16; const int b = ml ? (t2 >> 2) : (t2 >> 3), hh = ml ? (t2 & 3) : (t2 & 7);
        const float bfv = ml ? p->in[36][hh] : p->in[38][hh], biv = ml ? p->in[35][hh] : 0.f; const int fcol = ml ? 4 + hh : 8 + hh, icol = hh;
        float* fF = (float*)(p->ws + OFF_FF) + (size_t)t2 * SEQ; float* mA = (float*)(p->ws + OFF_MA) + (size_t)t2 * SEQ; float* mM = (float*)(p->ws + OFF_MM) + (size_t)t2 * SEQ; float* mT = (float*)(p->ws + OFF_MTT) + (size_t)t2 * SEQ;
        double* shd = (double*)lds; float* shm = (float*)(lds + 64);
        const int pos0 = wid * 512 + lane; const float* Gf = G + (size_t)fcol * MT + (size_t)b * SEQ + pos0; const float* Gi = G + (size_t)icol * MT + (size_t)b * SEQ + pos0;
        float v[8], ig[8];
#pragma unroll
        for (int ch = 0; ch < 8; ++ch) { v[ch] = logsig(Gf[ch * 64] + bfv); ig[ch] = ml ? Gi[ch * 64] + biv : 0.f; }
#pragma unroll
        for (int off = 1; off < 64; off <<= 1) {
#pragma unroll
            for (int ch = 0; ch < 8; ++ch) { const float t = __shfl_up(v[ch], off); if (lane >= off) v[ch] += t; }
        }
        double Fl[8]; double Fc = 0.0;
#pragma unroll
        for (int ch = 0; ch < 8; ++ch) { const float tot = __shfl(v[ch], 63); Fl[ch] = Fc + (double)v[ch]; Fc += (double)tot; }
        __syncthreads();
        if (lane == 0) shd[wid] = Fc;
        __syncthreads();
        double base = 0.0;
        for (int w2 = 0; w2 < wid; ++w2) base += shd[w2];
        float Fv[8];
#pragma unroll
        for (int ch = 0; ch < 8; ++ch) Fv[ch] = (float)(base + Fl[ch]);
        if (!ml) {
#pragma unroll
            for (int ch = 0; ch < 8; ++ch) fF[pos0 + ch * 64] = Fv[ch];
        } else {
            float a[8], cm[8];
#pragma unroll
            for (int ch = 0; ch < 8; ++ch) { a[ch] = ig[ch] - Fv[ch]; cm[ch] = a[ch]; mA[pos0 + ch * 64] = a[ch] * LOG2E; }
#pragma unroll
            for (int off = 1; off < 64; off <<= 1) {
#pragma unroll
                for (int ch = 0; ch < 8; ++ch) { const float t = __shfl_up(cm[ch], off); if (lane >= off) cm[ch] = fmaxf(cm[ch], t); }
            }
            float Mc = -3.0e38f; float Ml[8];
#pragma unroll
            for (int ch = 0; ch < 8; ++ch) { const float tot = __shfl(cm[ch], 63); Ml[ch] = fmaxf(Mc, cm[ch]); Mc = fmaxf(Mc, tot); }
            if (lane == 0) shm[wid] = Mc;
            __syncthreads();
            float bm = 0.f;
            for (int w2 = 0; w2 < wid; ++w2) bm = fmaxf(bm, shm[w2]);
#pragma unroll
            for (int ch = 0; ch < 8; ++ch) { const float Mr = fmaxf(bm, Ml[ch]); mM[pos0 + ch * 64] = Mr * LOG2E; mT[pos0 + ch * 64] = Fv[ch] + Mr; }
        }
    }
    const float* cw = p->in[33]; const float* cbv = p->in[34];
    if ((int)blockIdx.x >= nscan)
    for (int idx = ((int)blockIdx.x - nscan) * 512 + tid; idx < MT * 64; idx += ((int)gridDim.x - nscan) * 512) {
        const int tok = idx >> 6, c8 = (idx & 63) * 8, pos = tok & (SEQ - 1);
        float acc[8];
#pragma unroll
        for (int e = 0; e < 8; ++e) acc[e] = cbv[c8 + e];
#pragma unroll
        for (int j = 0; j < 4; ++j) {
            if (pos - 3 + j >= 0) {
                const u32x4 xv = *(const u32x4*)(P1 + (size_t)(tok - 3 + j) * 2048 + c8); const f32x4 w0 = *(const f32x4*)(cw + j * 512 + c8), w1 = *(const f32x4*)(cw + j * 512 + c8 + 4);
                acc[0] += w0[0] * bflo(xv.x); acc[1] += w0[1] * bfhi(xv.x); acc[2] += w0[2] * bflo(xv.y); acc[3] += w0[3] * bfhi(xv.y);
                acc[4] += w1[0] * bflo(xv.z); acc[5] += w1[1] * bfhi(xv.z); acc[6] += w1[2] * bflo(xv.w); acc[7] += w1[3] * bfhi(xv.w);
            }
        }
        const float sc = c8 < 256 ? 0.125f : 1.0f;
#pragma unroll
        for (int e = 0; e < 8; ++e) acc[e] = acc[e] * sigmoidf_(acc[e]) * sc;
        u32x4 o; o.x = pack2(acc[0], acc[1]); o.y = pack2(acc[2], acc[3]); o.z = pack2(acc[4], acc[5]); o.w = pack2(acc[6], acc[7]);
        *(u32x4*)(QK + (size_t)tok * 512 + c8) = o;
    }
}

DI void phase_final(KPtr p) {
    const int tid_ = otid(); const int lane = tid_ & 63, wid = tid_ >> 6; const float* ssq = (const float*)(p->ws + OFF_SSQ); const float* gn = p->in[44]; float* out = p->out; const bf16_t* xbf = (const bf16_t*)(p->ws + OFF_XB);
    for (int row = blockIdx.x * 8 + wid; row < MT; row += gridDim.x * 8) {
        float s = lane < 16 ? ssq[(size_t)lane * MT + row] : 0.f;
#pragma unroll
        for (int off = 1; off < 16; off <<= 1) s += __shfl_xor(s, off);
        s = __shfl(s, 0);
        const float rstd = rsqrtf(s * (1.0f / 1024.0f) + NEPS);
#pragma unroll
        for (int i = 0; i < 4; ++i) { const size_t o = (size_t)row * DM + i * 256 + lane * 4; const u32x2 w0 = *(const u32x2*)(xbf + o); f32x4 v; v[0] = bflo(w0.x); v[1] = bfhi(w0.x); v[2] = bflo(w0.y); v[3] = bfhi(w0.y); const f32x4 gv = *(const f32x4*)(gn + i * 256 + lane * 4); *(f32x4*)(out + o) = v * gv * rstd; }
    }
}

#define XB_TMO      128
#define XB_XCNT(j)  (256  + 64 * (j))
#define XB_XSUB(j)  (1280 + 64 * (j))
#define XB_XGEN(j)  (2304 + 64 * (j))
#define XB_TOP      3328
#define XB_TOPGEN   3392
#define XB_SPIN_CAP (1u << 22)
DI unsigned xb_ld(unsigned* q) { return __hip_atomic_load(q, __ATOMIC_RELAXED, __HIP_MEMORY_SCOPE_AGENT); }
DI unsigned xb_add(unsigned* q, unsigned v) { return __hip_atomic_fetch_add(q, v, __ATOMIC_RELAXED, __HIP_MEMORY_SCOPE_AGENT); }
DI unsigned xb_xcc_id() { return (unsigned)__builtin_amdgcn_s_getreg((3 << 11) | 20) & 0xFu; }
#define XB_SPIN(cond, bar) do { unsigned _sp = 0; while (cond) { __builtin_amdgcn_s_sleep(1); \
    if ((++_sp & 255u) == 0u) { if (xb_ld(&(bar)[XB_TMO])) break; if (_sp > XB_SPIN_CAP) { atomicAdd(&(bar)[XB_TMO], 1u); break; } } } } while (0)
DI void xcd_barrier_complete(unsigned* bar, unsigned x, unsigned& nloc, unsigned& nx) {
    const unsigned G = gridDim.x; unsigned sum, cnt, mine, sp = 0u;
    for (;;) {
        sum = 0u; cnt = 0u; mine = 0u;
#pragma unroll
        for (unsigned j = 0; j < 16; ++j) { const unsigned c = xb_ld(&bar[XB_XCNT(j)]); sum += c; cnt += (c > 0u) ? 1u : 0u; mine = (j == x) ? c : mine; }
        if (sum == G) break;
        __builtin_amdgcn_s_sleep(1);
        if ((++sp & 255u) == 0u) { if (xb_ld(&bar[XB_TMO])) break; if (sp > XB_SPIN_CAP) { atomicAdd(&bar[XB_TMO], 1u); break; } }
    }
    nloc = mine > 0u ? mine : 1u; nx = cnt > 0u ? cnt : 1u;
}
DI void grid_barrier(unsigned* bar, volatile unsigned* st) {
    asm volatile("s_waitcnt vmcnt(0)" ::: "memory");
    __syncthreads();
    if (threadIdx.x == 0) {
        const unsigned x = xb_xcc_id();
        __builtin_amdgcn_s_waitcnt(0);
        unsigned nloc = st[0], nx = st[1];
        if (nloc == 0u) { xcd_barrier_complete(bar, x, nloc, nx); st[0] = nloc; st[1] = nx; }
        const unsigned old = xb_add(&bar[XB_XSUB(x)], 1u);
        const unsigned gen = old / nloc;
        if (old + 1u == (gen + 1u) * nloc) {
            __builtin_amdgcn_fence(__ATOMIC_RELEASE, "agent");
            asm volatile("s_waitcnt vmcnt(0)" ::: "memory");
            const unsigned og = xb_add(&bar[XB_TOP], 1u);
            const unsigned tg = og / nx;
            if (og + 1u == (tg + 1u) * nx) xb_add(&bar[XB_TOPGEN], 1u);
            else XB_SPIN(xb_ld(&bar[XB_TOPGEN]) == tg, bar);
            __builtin_amdgcn_fence(__ATOMIC_ACQUIRE, "agent");
            xb_add(&bar[XB_XGEN(x)], 1u);
            asm volatile("s_waitcnt vmcnt(0)" ::: "memory");
        } else {
            XB_SPIN(xb_ld(&bar[XB_XGEN(x)]) == gen, bar);
            __builtin_amdgcn_fence(__ATOMIC_ACQUIRE, "agent");
            asm volatile("s_waitcnt vmcnt(0)" ::: "memory");
        }
    }
    __syncthreads();
}

#ifdef NO_S5
#define S5P1(...)
#define S5P3(...)
#else
#define S5P1(...) s5_pass1(__VA_ARGS__)
#define S5P3(...) s5_pass3(__VA_ARGS__)
#endif
#ifdef NO_ATT0
#define ATT0(...)
#else
#define ATT0(...) attn_item<0, 128>(__VA_ARGS__)
#endif
#ifdef NO_ATT1
#define ATT1(...)
#else
#define ATT1(...) attn_item<1, 64>(__VA_ARGS__)
#endif
#ifdef NO_ATT2
#define ATT2(...)
#else
#define ATT2(...) attn_item<2, 128>(__VA_ARGS__)
#endif
#ifdef NO_GEMM
#define GEMM(...)
#else
#define GEMM(...) pg8::gemm_phase<__VA_ARGS__
#endif
DI int next_item_xcd(unsigned* ctrs, int nper, unsigned char* lds) {
    volatile int* si = (volatile int*)(lds + LDS_MISC);
    __syncthreads();
    if (threadIdx.x == 0) {
        const unsigned x0 = xb_xcc_id() & 7u; int res = -1;
        for (unsigned k = 0; k < 8u; ++k) { const unsigned q = (x0 + k) & 7u; if (xb_ld(&ctrs[q]) >= (unsigned)nper) continue; const unsigned v = xb_add(&ctrs[q], 1u); if (v < (unsigned)nper) { res = (int)(q * (unsigned)nper + v); break; } }
        *si = res;
    }
    __syncthreads();
    return *si;
}
__global__ void __launch_bounds__(512, 2) fwd_kernel(Params karg) {
    extern __shared__ __attribute__((aligned(16))) unsigned char lds[];
    cg::grid_group grid = cg::this_grid();
    {
        volatile unsigned* st = (volatile unsigned*)(lds + LDS_MISC + 16);
        if (threadIdx.x == 0) { st[0] = 0u; st[1] = 0u; }
        __syncthreads();
        KPtr p0 = launder_kp();
        if (p0->ws == nullptr) grid.sync();
        if (threadIdx.x == 0) (void)xb_add(&((unsigned*)(p0->ws + OFF_BAR))[XB_XCNT(xb_xcc_id())], 1u);
    }
#define GBAR() do { KPtr pb_ = launder_kp(); grid_barrier((unsigned*)(pb_->ws + OFF_BAR), (volatile unsigned*)(lds + LDS_MISC + 16)); } while (0)
#define PH_VARS KPtr p = launder_kp(); PG8_LAS unsigned char* l3 = (PG8_LAS unsigned char*)lds; const int G = osgpr(gridDim.x), c = osgpr(blockIdx.x); unsigned char* ws = p->ws; const char* xb = (const char*)(ws + OFF_XB); float* ssq = (float*)(ws + OFF_SSQ); unsigned* ctr = (unsigned*)(ws + OFF_SCAL) + 8; (void)l3; (void)G; (void)c; (void)xb; (void)ssq; (void)ctr;
    {
        PH_VARS
#ifndef NO_PREP
        phase_prep(p, lds);
#endif
    }
    GBAR();
    for (int f = 0; f < 4; ++f) {
        {
            PH_VARS
            pg8::Sched2 S{64, 22, 1408, 0, 0, 0, G, c, xb, (const char*)(ws + (size_t)f * SZ_FFN), nullptr, nullptr};
            EpiGateUp E{ssq, (bf16_t*)(ws + OFF_HID)}; rstd_cache_reset();
#if !defined(ONLY_G) || ONLY_G == 0
            pg8::gemm_phase<EpiGateUp, pg8::Sched2>(l3, 1024, S, E, nullptr);
#endif
        }
        GBAR();
        {
            PH_VARS
            pg8::Sched2 S{64, 4, 256, 0, 0, 0, G, c, (const char*)(ws + OFF_HID), (const char*)(ws + (size_t)f * SZ_FFN + SZ_WGU), nullptr, nullptr};
            EpiResid E{f == 0 ? p->in[0] : (const float*)nullptr, (bf16_t*)(ws + OFF_XB), ssq, 0.5f};
#if !defined(ONLY_G) || ONLY_G == 1
            pg8::gemm_phase<EpiResid, pg8::Sched2>(l3, FFH, S, E, nullptr);
#endif
        }
        GBAR();
        if (f == 0) {
            {
                PH_VARS
                pg8::Sched2 S{64, 6, 384, 2, 64, 128, G, c, xb, (const char*)(ws + OFF_WIN0), (const char*)(ws + OFF_WIN0 + (size_t)1536 * 1024 * 2), xb};
                EpiWin0 E{ssq, (bf16_t*)(ws + OFF_P0), (bf16_t*)(ws + OFF_VT0), (const f32x2*)(ws + OFF_ROPE)}; rstd_cache_reset();
#if !defined(ONLY_G) || ONLY_G == 2
                pg8::gemm_phase<EpiWin0, pg8::Sched2>(l3, 1024, S, E, nullptr);
#endif
            }
            GBAR();
            {
                PH_VARS
                for (;;) {
                    const int it = next_item_xcd(ctr + 0, 128, lds); if (it < 0) break;
                    const int x = it >> 7, j = it & 127;
                    const int s5lo = osgpr(0);
                    if (j >= s5lo && j < s5lo + 64) { S5P1(p, lds, x * 64 + (j - s5lo)); }
                    else { const int idx = j < s5lo ? j : j - 64; const int qblk = 31 - (idx >> 1), bh = 2 * x + (idx & 1); ATT0(p, lds, bh >> 2, bh & 3, qblk); }
                }
            }
            GBAR();
            {
                PH_VARS
                for (int it = c; it < 512; it += G) { S5P3(p, lds, it); }
            }
            GBAR();
            {
                PH_VARS
                pg8::Sched2 S{64, 2, 128, 0, 0, 0, G, c, (const char*)(ws + OFF_Z), (const char*)(ws + OFF_WGLU), nullptr, nullptr};
                EpiGLU E{(const bf16_t*)(ws + OFF_Z), p->in[21], (bf16_t*)(ws + OFF_YC0)};
#if !defined(ONLY_G) || ONLY_G == 3
                pg8::gemm_phase<EpiGLU, pg8::Sched2>(l3, 512, S, E, nullptr);
#endif
            }
            GBAR();
        }
        if (f == 2) {
            {
                PH_VARS
                pg8::Sched2 S{64, 8, 512, 4, 64, 256, G, c, xb, (const char*)(ws + OFF_WIN1), (const char*)(ws + OFF_WIN1 + (size_t)2304 * 1024 * 2), xb};
                EpiWin1 E{ssq, (bf16_t*)(ws + OFF_P1), (bf16_t*)(ws + OFF_VT1), (float*)(ws + OFF_GATES)}; rstd_cache_reset();
#if !defined(ONLY_G) || ONLY_G == 4
                pg8::gemm_phase<EpiWin1, pg8::Sched2>(l3, 1024, S, E, nullptr);
#endif
                gates_job(p);
            }
            GBAR();
            {
                PH_VARS
#ifndef NO_L1PREP
                phase_l1prep(p, lds);
#endif
            }
            GBAR();
            {
                PH_VARS
                for (;;) {
                    const int it = next_item_xcd(ctr + 8, 80, lds); if (it < 0) break;
                    const int x = it / 80, j = it % 80;
                    if (j < 16) { mlstm_local(p, lds, x * 16 + j); }
                    else { const int jj = j - 16, qblk = 15 - jj / 4, bh = 4 * x + (jj & 3); ATT1(p, lds, bh >> 3, bh & 7, qblk); }
                }
            }
            GBAR();
            {
                PH_VARS
                mlstm_prefix(p);
            }
            GBAR();
            {
                PH_VARS
                for (int it = c; it < 256; it += G) { const int bh = it & 15, qblk = it >> 4; attn_item<2, 128, true>(p, lds, bh >> 2, bh & 3, qblk); __syncthreads(); }
            }
            GBAR();
        }
        if (f == 0 || f == 2) {
            PH_VARS
            pg8::Sched2 S{64, 4, 256, 0, 0, 0, G, c, (const char*)(ws + (f == 0 ? OFF_YC0 : OFF_YC1)), (const char*)(ws + (f == 0 ? OFF_WOUT0 : OFF_WOUT1)), nullptr, nullptr};
            EpiResid E{(const float*)nullptr, (bf16_t*)(ws + OFF_XB), ssq, 1.0f};
#if !defined(ONLY_G) || ONLY_G == 5
            pg8::gemm_phase<EpiResid, pg8::Sched2>(l3, 1024, S, E, nullptr);
#endif
        }
        if (f == 0 || f == 2) GBAR();
    }
    {
        PH_VARS
        phase_final(p);
    }
}

extern "C" void kernel_launch(void* const* d_in, const int* in_sizes, int n_in, void* d_out, int out_size, void* d_ws, size_t ws_size, hipStream_t stream) {
    static int grid_blocks = 0;
    if (!grid_blocks) {
        int dev = 0, cus = 0, per_cu = 0;
        (void)hipGetDevice(&dev);
        (void)hipDeviceGetAttribute(&cus, hipDeviceAttributeMultiprocessorCount, dev);
        (void)hipFuncSetAttribute((const void*)fwd_kernel, hipFuncAttributeMaxDynamicSharedMemorySize, LDS_BYTES);
        (void)hipOccupancyMaxActiveBlocksPerMultiprocessor(&per_cu, (const void*)fwd_kernel, 512, LDS_BYTES);
        if (per_cu < 1) per_cu = 1;
        grid_blocks = cus * per_cu;
        if (n_in != 45 || ws_size < WS_END) fprintf(stderr, "kernel_launch: unexpected n_in %d / ws %zu\n", n_in, ws_size);
    }
    Params p{};
    for (int i = 0; i < 45; ++i) p.in[i] = (const float*)d_in[i];
    p.out = (float*)d_out; p.ws = (unsigned char*)d_ws;
    for (int i = 0; i < 8; ++i) p.inv_freq[i] = (float)pow(500000.0, -(double)(2 * i) / 16.0);
    (void)hipMemsetAsync((unsigned char*)d_ws + OFF_BAR, 0, BAR_BYTES, stream);
    void* args[] = {&p};
    hipError_t e = hipLaunchCooperativeKernel((const void*)fwd_kernel, dim3(grid_blocks), dim3(512), args, LDS_BYTES, stream);
    if (e != hipSuccess) fprintf(stderr, "cooperative launch failed: %s (grid %d)\n", hipGetErrorString(e), grid_blocks);
}
```
